# Optimizing an MI355X kernel written in HIP

```python
import math
import jax, jax.numpy as jnp
from jax import lax
import numpy as np

D_MODEL = 2048
BATCH = 8
SEQ = 2048
DEPTH = 2

EPS = 1e-6
ROPE_THETA = 10000.0
Q_BLOCK = 128
NEG_INF = -1e30

MLA_HEADS = D_MODEL // 128
MLA_Q_LORA = D_MODEL // 4
MLA_KV_LORA = D_MODEL // 4
MLA_NOPE = 128
MLA_ROPE = 64
MLA_V = 128
MLA_DOWN = MLA_Q_LORA + MLA_KV_LORA + MLA_ROPE

DIL_PAIRS = ((128, 1), (512, 4), (2048, 16))
DIL_GROUPS = len(DIL_PAIRS)
DIL_HEADS = D_MODEL // 128
DIL_HEAD_DIM = 128

FFN_HIDDEN = ((8 * D_MODEL + 3 * 256 - 1) // (3 * 256)) * 256

kernel_name = "hybrid_mla_dilated_swiglu"


def rms_norm(x, gain):
    xf = x.astype(jnp.float32)
    y = xf * lax.rsqrt(jnp.mean(xf * xf, axis=-1, keepdims=True) + EPS)
    return (y * gain.astype(jnp.float32)).astype(x.dtype)


def apply_rope(x, positions):
    dim = x.shape[-1]
    half = dim // 2
    inv_freq = jnp.power(ROPE_THETA, -2.0 * jnp.arange(half, dtype=jnp.float32) / dim)
    ang = positions.astype(jnp.float32)[..., None] * inv_freq
    ang = ang.reshape(ang.shape[:2] + (1,) * (x.ndim - 3) + (half,))
    cos, sin = jnp.cos(ang), jnp.sin(ang)
    xf = x.astype(jnp.float32)
    x1, x2 = xf[..., :half], xf[..., half:]
    return jnp.concatenate([x1 * cos - x2 * sin, x2 * cos + x1 * sin], axis=-1).astype(x.dtype)


def causal_block_attention(q, k, v, scale):
    B, S, H, Dk = q.shape
    Dv = v.shape[-1]
    nb = S // Q_BLOCK
    qb = q.reshape(B, nb, Q_BLOCK, H, Dk).transpose(1, 0, 2, 3, 4)
    kpos = jnp.arange(S)

    def one_block(args):
        qblk, start = args
        s = jnp.einsum('bqhd,bkhd->bhqk', qblk, k, preferred_element_type=jnp.float32) * scale
        qpos = start + jnp.arange(Q_BLOCK)
        mask = kpos[None, :] <= qpos[:, None]
        s = jnp.where(mask[None, None], s, NEG_INF)
        p = jax.nn.softmax(s, axis=-1)
        return jnp.einsum('bhqk,bkhd->bqhd', p.astype(v.dtype), v)

    o = lax.map(one_block, (qb, jnp.arange(nb) * Q_BLOCK))
    return o.transpose(1, 0, 2, 3, 4).reshape(B, S, H, Dv)


def strided_window_attention(q, k, v, dilation, span, scale):
    B, S, H, Dh = q.shape
    L = S // dilation
    N = B * dilation

    def to_residue(t):
        return t.reshape(B, L, dilation, H, Dh).transpose(0, 2, 1, 3, 4).reshape(N, L, H, Dh)

    qr, kr, vr = to_residue(q), to_residue(k), to_residue(v)
    blk = math.gcd(L, Q_BLOCK)
    nb = L // blk
    slab = span + blk
    pad = ((0, 0), (span, 0), (0, 0), (0, 0))
    kp, vp = jnp.pad(kr, pad), jnp.pad(vr, pad)
    idx = jnp.arange(nb)[:, None] * blk + jnp.arange(slab)[None, :]
    kb, vb = kp[:, idx], vp[:, idx]
    qb = qr.reshape(N, nb, blk, H, Dh)
    s = jnp.einsum('nbqhd,nbkhd->nbhqk', qb, kb, preferred_element_type=jnp.float32) * scale
    i = jnp.arange(blk)[:, None]
    j = jnp.arange(slab)[None, :]
    dist = i + span - j
    key_pos = jnp.arange(nb)[:, None, None] * blk + j[None] - span
    valid = (dist >= 0) & (dist <= span) & (key_pos >= 0)
    s = jnp.where(valid[None, :, None], s, NEG_INF)
    m = jnp.max(s, axis=-1, keepdims=True)
    p = jnp.exp(s - m)
    l = jnp.sum(p, axis=-1, keepdims=True)
    o = jnp.einsum('nbhqk,nbkhd->nbqhd', (p / l).astype(v.dtype), vb)
    lse = (m + jnp.log(l))[..., 0]
    o = o.reshape(B, dilation, L, H, Dh).transpose(0, 2, 1, 3, 4).reshape(B, S, H, Dh)
    lse = lse.transpose(0, 1, 3, 2).reshape(B, dilation, L, H).transpose(0, 2, 1, 3).reshape(B, S, H)
    return o, lse


def mla_mixer(h, positions, w_down, q_norm, kv_norm, w_uq, w_ukv, q_gain, k_gain, w_o):
    B, S, _ = h.shape
    down = jnp.einsum('bsd,de->bse', h, w_down)
    c_q = rms_norm(down[..., :MLA_Q_LORA], q_norm)
    c_kv = rms_norm(down[..., MLA_Q_LORA:MLA_Q_LORA + MLA_KV_LORA], kv_norm)
    k_rope_raw = down[..., MLA_Q_LORA + MLA_KV_LORA:]
    q = jnp.einsum('bsr,re->bse', c_q, w_uq).reshape(B, S, MLA_HEADS, MLA_NOPE + MLA_ROPE)
    kv = jnp.einsum('bsr,re->bse', c_kv, w_ukv).reshape(B, S, MLA_HEADS, MLA_NOPE + MLA_V)
    q_nope = rms_norm(q[..., :MLA_NOPE], q_gain[:MLA_NOPE])
    q_rope = apply_rope(rms_norm(q[..., MLA_NOPE:], q_gain[MLA_NOPE:]), positions)
    k_nope = rms_norm(kv[..., :MLA_NOPE], k_gain[:MLA_NOPE])
    k_rope = apply_rope(rms_norm(k_rope_raw, k_gain[MLA_NOPE:]), positions)
    v = kv[..., MLA_NOPE:]
    q = jnp.concatenate([q_nope, q_rope], axis=-1)
    k = jnp.concatenate([k_nope, jnp.broadcast_to(k_rope[:, :, None, :], (B, S, MLA_HEADS, MLA_ROPE))], axis=-1)
    o = causal_block_attention(q, k, v, 1.0 / math.sqrt(MLA_NOPE + MLA_ROPE))
    return jnp.einsum('bse,ed->bsd', o.reshape(B, S, MLA_HEADS * MLA_V), w_o)


def dilated_mixer(h, positions, w_qkv, q_gain, k_gain, w_o):
    B, S, _ = h.shape
    qkv = jnp.einsum('bsd,de->bse', h, w_qkv).reshape(B, S, 3, DIL_GROUPS, DIL_HEADS, DIL_HEAD_DIM)
    q = apply_rope(rms_norm(qkv[:, :, 0], q_gain[:, None, :]), positions)
    k = apply_rope(rms_norm(qkv[:, :, 1], k_gain[:, None, :]), positions)
    v = qkv[:, :, 2]
    scale = 1.0 / math.sqrt(DIL_HEAD_DIM)
    outs, lses = [], []
    for g, (window, dilation) in enumerate(DIL_PAIRS):
        o_g, lse_g = strided_window_attention(q[:, :, g], k[:, :, g], v[:, :, g], dilation, window // dilation, scale)
        outs.append(o_g)
        lses.append(lse_g)
    wts = jax.nn.softmax(jnp.stack(lses, axis=0), axis=0)
    o = jnp.sum(wts[..., None] * jnp.stack(outs, axis=0).astype(jnp.float32), axis=0).astype(h.dtype)
    return jnp.einsum('bse,ed->bsd', o.reshape(B, S, DIL_HEADS * DIL_HEAD_DIM), w_o)


def swiglu(h, w_gate, w_up, w_down):
    a = jax.nn.silu(jnp.einsum('bsd,df->bsf', h, w_gate)) * jnp.einsum('bsd,df->bsf', h, w_up)
    return jnp.einsum('bsf,fd->bsd', a, w_down)


def setup_inputs(seed: int = 0) -> dict:
    key = jax.random.key(seed)
    ks = jax.random.split(key, 24)
    n_a = (DEPTH + 1) // 2
    n_b = DEPTH // 2
    f32 = jnp.float32

    def nrm(k, shape, fan_in):
        return jax.random.normal(k, shape, f32) * (fan_in ** -0.5)

    def gain(k, shape):
        return 1.0 + 0.05 * jax.random.normal(k, shape, f32)

    x = jax.random.normal(ks[0], (BATCH, SEQ, D_MODEL), f32)
    offsets = jax.random.randint(ks[1], (BATCH, 1), 0, 4096, dtype=jnp.int32)
    positions = offsets + jnp.arange(SEQ, dtype=jnp.int32)[None, :]
    return {
        "x": x,
        "positions": positions,
        "mixer_norm": gain(ks[2], (DEPTH, D_MODEL)),
        "ffn_norm": gain(ks[3], (DEPTH, D_MODEL)),
        "mla_w_down": nrm(ks[4], (n_a, D_MODEL, MLA_DOWN), D_MODEL),
        "mla_q_norm": gain(ks[5], (n_a, MLA_Q_LORA)),
        "mla_kv_norm": gain(ks[6], (n_a, MLA_KV_LORA)),
        "mla_w_uq": nrm(ks[7], (n_a, MLA_Q_LORA, MLA_HEADS * (MLA_NOPE + MLA_ROPE)), MLA_Q_LORA),
        "mla_w_ukv": nrm(ks[8], (n_a, MLA_KV_LORA, MLA_HEADS * (MLA_NOPE + MLA_V)), MLA_KV_LORA),
        "mla_q_gain": gain(ks[9], (n_a, MLA_NOPE + MLA_ROPE)),
        "mla_k_gain": gain(ks[10], (n_a, MLA_NOPE + MLA_ROPE)),
        "mla_w_o": nrm(ks[11], (n_a, MLA_HEADS * MLA_V, D_MODEL), MLA_HEADS * MLA_V),
        "dil_w_qkv": nrm(ks[12], (n_b, D_MODEL, 3 * DIL_GROUPS * DIL_HEADS * DIL_HEAD_DIM), D_MODEL),
        "dil_q_gain": gain(ks[13], (n_b, DIL_GROUPS, DIL_HEAD_DIM)),
        "dil_k_gain": gain(ks[14], (n_b, DIL_GROUPS, DIL_HEAD_DIM)),
        "dil_w_o": nrm(ks[15], (n_b, DIL_HEADS * DIL_HEAD_DIM, D_MODEL), DIL_HEADS * DIL_HEAD_DIM),
        "ffn_w_gate": nrm(ks[16], (DEPTH, D_MODEL, FFN_HIDDEN), D_MODEL),
        "ffn_w_up": nrm(ks[17], (DEPTH, D_MODEL, FFN_HIDDEN), D_MODEL),
        "ffn_w_down": nrm(ks[18], (DEPTH, FFN_HIDDEN, D_MODEL), FFN_HIDDEN),
    }


def reference(x, positions, mixer_norm, ffn_norm, mla_w_down, mla_q_norm, mla_kv_norm, mla_w_uq,
              mla_w_ukv, mla_q_gain, mla_k_gain, mla_w_o, dil_w_qkv, dil_q_gain, dil_k_gain, dil_w_o,
              ffn_w_gate, ffn_w_up, ffn_w_down):
    for i in range(DEPTH):
        h = rms_norm(x, mixer_norm[i])
        j = i // 2
        if i % 2 == 0:
            mix = mla_mixer(h, positions, mla_w_down[j], mla_q_norm[j], mla_kv_norm[j], mla_w_uq[j],
                            mla_w_ukv[j], mla_q_gain[j], mla_k_gain[j], mla_w_o[j])
        else:
            mix = dilated_mixer(h, positions, dil_w_qkv[j], dil_q_gain[j], dil_k_gain[j], dil_w_o[j])
        x = x + mix
        x = x + swiglu(rms_norm(x, ffn_norm[i]), ffn_w_gate[i], ffn_w_up[i], ffn_w_down[i])
    return x
```

```cpp
#include <hip/hip_runtime.h>
#include <hip/hip_cooperative_groups.h>
#include <cstdio>
#include <cstdint>
namespace cg = cooperative_groups;
namespace pg8 {
#define PG8_LAS __attribute__((address_space(3)))
typedef unsigned short bf16_t;
typedef short bf16x8 __attribute__((ext_vector_type(8)));
typedef float f32x4 __attribute__((ext_vector_type(4)));
typedef unsigned u32x4 __attribute__((ext_vector_type(4)));
constexpr int BM = 256, BK = 64, HALF = 128, HTB = HALF * BK * 2  , STAGE_BYTES = 8 * HTB, NXCD = 8, WGM = 4;

__host__ __device__ __forceinline__ int lds_byte(int r, int c) { const int st = (r >> 4) * 2 + (c >> 5), rr = r & 15, cc = c & 31, ob = rr * 64 + cc * 2; return st * 1024 + (ob ^ (((ob >> 9) & 1) << 5)); }
__host__ __device__ __forceinline__ void stage_rc(int b, int& R, int& C) { const int st = b / 1024, sb = b % 1024, swz = sb ^ (((sb >> 9) & 1) << 5); R = (st >> 1) * 16 + swz / 64; C = (st & 1) * 32 + (swz % 64) / 2; }
__host__ __device__ __forceinline__ int perm32(int rho) { const int n = rho >> 4, i = rho & 15; return 8 * (i >> 2) + 4 * n + (i & 3); }

struct Unit { int pm, pn; };
struct Gemm { const bf16_t* A; const bf16_t* Bt; int M, N, K; };

struct StaticOrder {
    int nM, nN, nwg, G, c, wgm;
    __host__ __device__ void init(int M, int N, int G_, int c_, int wgm_ = WGM) { nM = M / BM; nN = N / BM; nwg = nM * nN; G = G_; c = c_; wgm = wgm_; }
    __host__ __device__ bool next(int i, Unit& u) const {
        const long L = (long)i * G + c; if (L >= nwg) return false;
        int wgid = (int)L; { const int q = nwg / NXCD, r = nwg % NXCD, xcd = wgid % NXCD, off = wgid / NXCD; wgid = (xcd < r ? xcd * (q + 1) : r * (q + 1) + (xcd - r) * q) + off; }
        const int nig = wgm * nN, gid = wgid / nig, fm = gid * wgm, gsz = (nM - fm) < wgm ? (nM - fm) : wgm;
        u.pm = fm + ((wgid % nig) % gsz); u.pn = (wgid % nig) / gsz; return true;
    }
    __device__ __forceinline__ void a_ready(const Unit&) const {}
    __device__ __forceinline__ void done(const Unit&) const {}
};
__device__ __forceinline__ unsigned cvt_pk_bf16(float lo, float hi) { unsigned r; asm volatile("v_cvt_pk_bf16_f32 %0, %1, %2" : "=v"(r) : "v"(lo), "v"(hi)); return r; }
typedef float f32x2 __attribute__((ext_vector_type(2)));
struct EpiStoreBf16 {
    static constexpr bool PERM = true, AFTER_DRAIN = false;
    bf16_t* O; int ldc;
    __device__ __forceinline__ void operator()(const f32x4 (&acc)[2][2][4][2], const Unit& u, int wr, int wc, int fr, int fq) const {
        const int row0 = u.pm * BM + wr * 64 + fr, col0 = u.pn * BM + wc * 32 + 8 * fq;
#pragma unroll
        for (int ai = 0; ai < 2; ++ai)
#pragma unroll
            for (int m = 0; m < 4; ++m) { bf16_t* rowp = O + (size_t)(row0 + ai * HALF + m * 16) * ldc + col0;
#pragma unroll
                for (int bj = 0; bj < 2; ++bj) { const f32x4 v0 = acc[ai][bj][m][0], v1 = acc[ai][bj][m][1];
                    u32x4 w; w.x = cvt_pk_bf16(v0[0], v0[1]); w.y = cvt_pk_bf16(v0[2], v0[3]); w.z = cvt_pk_bf16(v1[0], v1[1]); w.w = cvt_pk_bf16(v1[2], v1[3]);
                    *(u32x4*)(rowp + bj * HALF) = w; } }
    }
};
struct EpiResF32 {
    static constexpr bool PERM = true, AFTER_DRAIN = false;
    const float* base; float* out; int ldc;
    __device__ __forceinline__ void operator()(const f32x4 (&acc)[2][2][4][2], const Unit& u, int wr, int wc, int fr, int fq) const {
        const int row0 = u.pm * BM + wr * 64 + fr, col0 = u.pn * BM + wc * 32 + 8 * fq;
#pragma unroll
        for (int ai = 0; ai < 2; ++ai)
#pragma unroll
            for (int m = 0; m < 4; ++m) { const size_t off = (size_t)(row0 + ai * HALF + m * 16) * ldc + col0;
#pragma unroll
                for (int bj = 0; bj < 2; ++bj)
#pragma unroll
                    for (int n = 0; n < 2; ++n) { const f32x4 b = *(const f32x4*)(base + off + bj * HALF + 4 * n);
                        *(f32x4*)(out + off + bj * HALF + 4 * n) = b + acc[ai][bj][m][n]; } }
    }
};
struct EpiSwiGLU {
    static constexpr bool PERM = true, AFTER_DRAIN = false;
    bf16_t* O; int ldc; const float* ss;
    static __device__ __forceinline__ float sw(float g, float up) { return g * __builtin_amdgcn_rcpf(1.f + __expf(-g)) * up; }
    __device__ __forceinline__ void operator()(const f32x4 (&acc)[2][2][4][2], const Unit& u, int wr, int wc, int fr, int fq) const {
        const int row0 = u.pm * BM + wr * 64 + fr, col0 = u.pn * HALF + wc * 32 + 8 * fq;
#pragma unroll
        for (int ai = 0; ai < 2; ++ai)
#pragma unroll
            for (int m = 0; m < 4; ++m) { bf16_t* rowp = O + (size_t)(row0 + ai * HALF + m * 16) * ldc + col0;
                const float rstd = rsqrtf(ss[row0 + ai * HALF + m * 16] * (1.f / 2048) + 1e-6f);
                const f32x4 g0 = acc[ai][0][m][0] * rstd, g1 = acc[ai][0][m][1] * rstd, u0 = acc[ai][1][m][0] * rstd, u1 = acc[ai][1][m][1] * rstd;
                u32x4 w; w.x = cvt_pk_bf16(sw(g0[0], u0[0]), sw(g0[1], u0[1])); w.y = cvt_pk_bf16(sw(g0[2], u0[2]), sw(g0[3], u0[3]));
                w.z = cvt_pk_bf16(sw(g1[0], u1[0]), sw(g1[1], u1[1])); w.w = cvt_pk_bf16(sw(g1[2], u1[2]), sw(g1[3], u1[3]));
                *(u32x4*)rowp = w; }
    }
};

struct EpiQKRope {
    static constexpr bool PERM = true, AFTER_DRAIN = false;
    bf16_t* O; int ldc; const unsigned* tab; const float* qgain; const float* kgain; float qscale; unsigned exb;
    __device__ __forceinline__ void operator()(const f32x4 (&acc)[2][2][4][2], const Unit& u, int wr, int wc, int fr_in, int fq_in) const {
        int fr = fr_in, fq = fq_in; asm volatile("" : "+v"(fr), "+v"(fq));
        const int row0 = u.pm * BM + wr * 64 + fr;
        if (u.pn >= 16) {
            const int col0 = u.pn * BM + wc * 32 + 8 * fq;
#pragma unroll
            for (int ai = 0; ai < 2; ++ai)
#pragma unroll
                for (int m = 0; m < 4; ++m) { bf16_t* rowp = O + (size_t)(row0 + ai * HALF + m * 16) * ldc + col0;
#pragma unroll
                    for (int bj = 0; bj < 2; ++bj) { const f32x4 v0 = acc[ai][bj][m][0], v1 = acc[ai][bj][m][1];
                        u32x4 w; w.x = cvt_pk_bf16(v0[0], v0[1]); w.y = cvt_pk_bf16(v0[2], v0[3]); w.z = cvt_pk_bf16(v1[0], v1[1]); w.w = cvt_pk_bf16(v1[2], v1[3]);
                        *(u32x4*)(rowp + bj * HALF) = w; } }
            return;
        }
        const int d0 = 16 * wc + 4 * fq;
        const unsigned xa = exb + 4096u * wr + 16u * fr;
        const unsigned wa = xa + 4u * wc;
#pragma unroll
        for (int ai = 0; ai < 2; ++ai)
#pragma unroll
            for (int m = 0; m < 4; ++m)
#pragma unroll
                for (int bj = 0; bj < 2; ++bj) { const f32x4 v0 = acc[ai][bj][m][0], v1 = acc[ai][bj][m][1];
                    float s = (v0[0] * v0[0] + v0[1] * v0[1]) + (v0[2] * v0[2] + v0[3] * v0[3]) + (v1[0] * v1[0] + v1[1] * v1[1]) + (v1[2] * v1[2] + v1[3] * v1[3]);
                    { float a_ = s, b_ = s; asm volatile("s_nop 1\n\tv_permlane16_swap_b32 %0, %1" : "+v"(a_), "+v"(b_)); a_ += b_; b_ = a_; asm volatile("s_nop 1\n\tv_permlane32_swap_b32 %0, %1" : "+v"(a_), "+v"(b_)); s = a_ + b_; }
                    if (fq == 0) asm volatile("ds_write_b32 %0, %1 offset:%2" :: "v"(wa), "v"(s), "n"(2048 * ai + 512 * m + 256 * bj) : "memory"); }
        u32x4 cs[2][4];
#pragma unroll
        for (int m = 0; m < 4; ++m) cs[0][m] = *(const u32x4*)(tab + (size_t)(row0 + m * 16) * 64 + d0);
        asm volatile("s_waitcnt lgkmcnt(0)" ::: "memory");
        __builtin_amdgcn_s_barrier();
        float rs[2][4][2];
#pragma unroll
        for (int ai = 0; ai < 2; ++ai)
#pragma unroll
            for (int m = 0; m < 4; ++m) { f32x4 p0, p1;
                asm volatile("ds_read_b128 %0, %2 offset:%3\n\tds_read_b128 %1, %2 offset:%4\n\ts_waitcnt lgkmcnt(0)" : "=&v"(p0), "=&v"(p1) : "v"(xa), "n"(2048 * ai + 512 * m), "n"(2048 * ai + 512 * m + 256) : "memory");
                rs[ai][m][0] = rsqrtf(((p0[0] + p0[1]) + (p0[2] + p0[3])) * (1.f / 128) + 1e-6f); rs[ai][m][1] = rsqrtf(((p1[0] + p1[1]) + (p1[2] + p1[3])) * (1.f / 128) + 1e-6f); }
#pragma unroll
        for (int m = 0; m < 4; ++m) cs[1][m] = *(const u32x4*)(tab + (size_t)(row0 + HALF + m * 16) * 64 + d0);
        const bool isq = u.pn < 8; const float* gain = isq ? qgain : kgain; const float sc = isq ? qscale : 1.f;
        const f32x4 g1 = *(const f32x4*)(gain + d0), g2 = *(const f32x4*)(gain + d0 + 64);
#pragma unroll
        for (int ai = 0; ai < 2; ++ai)
#pragma unroll
            for (int m = 0; m < 4; ++m) { const size_t tok = (size_t)(row0 + ai * HALF + m * 16);
                const u32x4 cw = cs[ai][m];
                f32x4 c4, s4;
                c4.x = (float)((int)(cw.x << 16) >> 16); c4.y = (float)((int)(cw.y << 16) >> 16); c4.z = (float)((int)(cw.z << 16) >> 16); c4.w = (float)((int)(cw.w << 16) >> 16);
                s4.x = (float)((int)cw.x >> 16); s4.y = (float)((int)cw.y >> 16); s4.z = (float)((int)cw.z >> 16); s4.w = (float)((int)cw.w >> 16);
                c4 = c4 * (1.f / 32767.f); s4 = s4 * (1.f / 32767.f);
                bf16_t* rowp = O + tok * ldc + u.pn * BM + d0;
#pragma unroll
                for (int bj = 0; bj < 2; ++bj) { const float r = rs[ai][m][bj];
                    const f32x4 y1 = acc[ai][bj][m][0] * r * g1, y2 = acc[ai][bj][m][1] * r * g2;
                    const f32x4 o1 = (y1 * c4 - y2 * s4) * sc, o2 = (y2 * c4 + y1 * s4) * sc;
                    typedef unsigned u32x2 __attribute__((ext_vector_type(2)));
                    u32x2 w1, w2; w1.x = cvt_pk_bf16(o1[0], o1[1]); w1.y = cvt_pk_bf16(o1[2], o1[3]); w2.x = cvt_pk_bf16(o2[0], o2[1]); w2.y = cvt_pk_bf16(o2[2], o2[3]);
                    *(u32x2*)(rowp + bj * HALF) = w1; *(u32x2*)(rowp + bj * HALF + 64) = w2; } }
    }
};

struct EpiKVNorm {
    static constexpr bool PERM = true, AFTER_DRAIN = false;
    bf16_t* O; int ldc; const float* kgain; unsigned exb;
    __device__ __forceinline__ void operator()(const f32x4 (&acc)[2][2][4][2], const Unit& u, int wr, int wc, int fr_in, int fq_in) const {
        int fr = fr_in, fq = fq_in; asm volatile("" : "+v"(fr), "+v"(fq));
        const int row0 = u.pm * BM + wr * 64 + fr, col0 = u.pn * BM + wc * 32 + 8 * fq;
        const unsigned xa = exb + 2048u * wr + 16u * fr, wa = xa + 4u * wc;
#pragma unroll
        for (int ai = 0; ai < 2; ++ai)
#pragma unroll
            for (int m = 0; m < 4; ++m) { const f32x4 v0 = acc[ai][0][m][0], v1 = acc[ai][0][m][1];
                float s = (v0[0] * v0[0] + v0[1] * v0[1]) + (v0[2] * v0[2] + v0[3] * v0[3]) + (v1[0] * v1[0] + v1[1] * v1[1]) + (v1[2] * v1[2] + v1[3] * v1[3]);
                { float a_ = s, b_ = s; asm volatile("s_nop 1\n\tv_permlane16_swap_b32 %0, %1" : "+v"(a_), "+v"(b_)); a_ += b_; b_ = a_; asm volatile("s_nop 1\n\tv_permlane32_swap_b32 %0, %1" : "+v"(a_), "+v"(b_)); s = a_ + b_; }
                if (fq == 0) asm volatile("ds_write_b32 %0, %1 offset:%2" :: "v"(wa), "v"(s), "n"(1024 * ai + 256 * m) : "memory"); }
#pragma unroll
        for (int ai = 0; ai < 2; ++ai)
#pragma unroll
            for (int m = 0; m < 4; ++m) { const f32x4 v0 = acc[ai][1][m][0], v1 = acc[ai][1][m][1];
                u32x4 w; w.x = cvt_pk_bf16(v0[0], v0[1]); w.y = cvt_pk_bf16(v0[2], v0[3]); w.z = cvt_pk_bf16(v1[0], v1[1]); w.w = cvt_pk_bf16(v1[2], v1[3]);
                *(u32x4*)(O + (size_t)(row0 + ai * HALF + m * 16) * ldc + col0 + HALF) = w; }
        asm volatile("s_waitcnt lgkmcnt(0)" ::: "memory");
        __builtin_amdgcn_s_barrier();
        const f32x4 g0 = *(const f32x4*)(kgain + wc * 32 + 8 * fq), g1 = *(const f32x4*)(kgain + wc * 32 + 8 * fq + 4);
#pragma unroll
        for (int ai = 0; ai < 2; ++ai)
#pragma unroll
            for (int mp = 0; mp < 2; ++mp) { f32x4 p0, p1;
                asm volatile("ds_read_b128 %0, %2 offset:%3\n\tds_read_b128 %1, %2 offset:%4\n\ts_waitcnt lgkmcnt(0)" : "=&v"(p0), "=&v"(p1) : "v"(xa), "n"(1024 * ai + 512 * mp), "n"(1024 * ai + 512 * mp + 256) : "memory");
                const float r0 = rsqrtf(((p0[0] + p0[1]) + (p0[2] + p0[3])) * (1.f / 128) + 1e-6f), r1 = rsqrtf(((p1[0] + p1[1]) + (p1[2] + p1[3])) * (1.f / 128) + 1e-6f);
                { const int m = 2 * mp; const f32x4 v0 = acc[ai][0][m][0] * r0 * g0, v1 = acc[ai][0][m][1] * r0 * g1;
                  u32x4 w; w.x = cvt_pk_bf16(v0[0], v0[1]); w.y = cvt_pk_bf16(v0[2], v0[3]); w.z = cvt_pk_bf16(v1[0], v1[1]); w.w = cvt_pk_bf16(v1[2], v1[3]);
                  *(u32x4*)(O + (size_t)(row0 + ai * HALF + m * 16) * ldc + col0) = w; }
                { const int m = 2 * mp + 1; const f32x4 v0 = acc[ai][0][m][0] * r1 * g0, v1 = acc[ai][0][m][1] * r1 * g1;
                  u32x4 w; w.x = cvt_pk_bf16(v0[0], v0[1]); w.y = cvt_pk_bf16(v0[2], v0[3]); w.z = cvt_pk_bf16(v1[0], v1[1]); w.w = cvt_pk_bf16(v1[2], v1[3]);
                  *(u32x4*)(O + (size_t)(row0 + ai * HALF + m * 16) * ldc + col0) = w; } }
    }
};

struct EpiResF32Stat {
    static constexpr bool PERM = true, AFTER_DRAIN = false;
    const float* base; float* out; int ldc; bf16_t* xb; float* ss;
    __device__ __forceinline__ void operator()(const f32x4 (&acc)[2][2][4][2], const Unit& u, int wr, int wc, int fr, int fq) const {
        const int row0 = u.pm * BM + wr * 64 + fr, col0 = u.pn * BM + wc * 32 + 8 * fq;
#pragma unroll
        for (int ai = 0; ai < 2; ++ai)
#pragma unroll
            for (int m = 0; m < 4; ++m) { const int row = row0 + ai * HALF + m * 16; const size_t off = (size_t)row * ldc + col0; float s = 0.f;
#pragma unroll
                for (int bj = 0; bj < 2; ++bj) { const f32x4 v0 = *(const f32x4*)(base + off + bj * HALF) + acc[ai][bj][m][0], v1 = *(const f32x4*)(base + off + bj * HALF + 4) + acc[ai][bj][m][1];
                    *(f32x4*)(out + off + bj * HALF) = v0; *(f32x4*)(out + off + bj * HALF + 4) = v1;
                    u32x4 w; w.x = cvt_pk_bf16(v0[0], v0[1]); w.y = cvt_pk_bf16(v0[2], v0[3]); w.z = cvt_pk_bf16(v1[0], v1[1]); w.w = cvt_pk_bf16(v1[2], v1[3]);
                    *(u32x4*)(xb + off + bj * HALF) = w;
                    s += (v0[0] * v0[0] + v0[1] * v0[1]) + (v0[2] * v0[2] + v0[3] * v0[3]) + (v1[0] * v1[0] + v1[1] * v1[1]) + (v1[2] * v1[2] + v1[3] * v1[3]); }
                { float a_ = s, b_ = s; asm volatile("s_nop 1\n\tv_permlane16_swap_b32 %0, %1" : "+v"(a_), "+v"(b_)); a_ += b_; b_ = a_; asm volatile("s_nop 1\n\tv_permlane32_swap_b32 %0, %1" : "+v"(a_), "+v"(b_)); s = a_ + b_; }
                if (fq == 0) __hip_atomic_fetch_add(ss + row, s, __ATOMIC_RELAXED, __HIP_MEMORY_SCOPE_AGENT); }
    }
};
template <class Epi, class Sched, bool ALIGN_EPI = false, bool SP2 = false>
__device__ __forceinline__ void gemm_phase(PG8_LAS unsigned char* lds, const Gemm g, const Sched& S, const Epi& E) {
    int tid_ = threadIdx.x; asm volatile("" : "+v"(tid_));
    const int tid = tid_, wid = __builtin_amdgcn_readfirstlane(tid >> 6), lane = tid & 63, wr = wid >> 2, wc = wid & 3, fr = lane & 15, fq = lane >> 4;
    const int K = g.K, nt = K / BK;
    unsigned voffA[2], voffB[2];
#pragma unroll
    for (int i = 0; i < 2; ++i) { int R, C; stage_rc(tid * 16 + i * 8192, R, C); const int Rb = Epi::PERM ? ((R & ~31) + perm32(R & 31)) : R;
        voffA[i] = (unsigned)(R * K + C) * 2u; voffB[i] = (unsigned)(Rb * K + C) * 2u; }
    const size_t kstep = (size_t)(BK * 2);
    const size_t hstep = (size_t)HALF * K * 2;
    const size_t tstep = 2 * hstep;
    const unsigned ldsw = (unsigned)wid * 1024u;
    const int aoff = lds_byte(wr * 64 + fr, fq * 8), boff = lds_byte(wc * 32 + fr, fq * 8);
#define PG8_SA(b, h) (((b) * 2 + (h)) * HTB)
#define PG8_SB(b, h) ((4 + (b) * 2 + (h)) * HTB)
#define PG8_STAGE(bufoff, gbase, voff) do { _Pragma("unroll") for (int _i = 0; _i < 2; ++_i) \
        __builtin_amdgcn_global_load_lds((const unsigned*)((const char*)(gbase) + (voff)[_i]), (PG8_LAS unsigned*)(lds + (bufoff) + ldsw + _i * 8192), 16, 0, 0); } while (0)
#define PG8_LDA(dst, b, h) do { _Pragma("unroll") for (int m = 0; m < 4; ++m) _Pragma("unroll") for (int k = 0; k < 2; ++k) dst[m][k] = *(const PG8_LAS bf16x8*)(lds + PG8_SA(b, h) + aoff + m * 2048 + k * 1024); } while (0)
#define PG8_LDB(dst, b, h) do { _Pragma("unroll") for (int n = 0; n < 2; ++n) _Pragma("unroll") for (int k = 0; k < 2; ++k) dst[n][k] = *(const PG8_LAS bf16x8*)(lds + PG8_SB(b, h) + boff + n * 2048 + k * 1024); } while (0)
#define PG8_MMA(ai, bj, At, Bt) do { __builtin_amdgcn_s_setprio(1); _Pragma("unroll") for (int m = 0; m < 4; ++m) _Pragma("unroll") for (int n = 0; n < 2; ++n) _Pragma("unroll") for (int k = 0; k < 2; ++k) \
        acc[ai][bj][m][n] = __builtin_amdgcn_mfma_f32_16x16x32_bf16(Bt[n][k], At[m][k], acc[ai][bj][m][n], 0, 0, 0); __builtin_amdgcn_s_setprio(0); } while (0)
#define PG8_WAIT_V(n) asm volatile("s_waitcnt vmcnt(" #n ")" ::: "memory")
#define PG8_WAIT_L(n) asm volatile("s_waitcnt lgkmcnt(" #n ")" ::: "memory")
#define PG8_BAR __builtin_amdgcn_s_barrier()
#define PG8_SCHED __builtin_amdgcn_sched_barrier(0)
    Unit cur, nxt; int ui = 0;
    if (!S.next(0, cur)) return;
    f32x4 acc[2][2][4][2];
#pragma unroll
    for (int a = 0; a < 2; ++a)
#pragma unroll
        for (int b = 0; b < 2; ++b)
#pragma unroll
            for (int m = 0; m < 4; ++m)
#pragma unroll
                for (int n = 0; n < 2; ++n) acc[a][b][m][n] = (f32x4){0.f, 0.f, 0.f, 0.f};
    bf16x8 At[4][2], B0[2][2], B1[2][2];
    const char* cA = (const char*)g.A + (size_t)cur.pm * tstep; const char* cB = (const char*)g.Bt + (size_t)cur.pn * tstep;
    S.a_ready(cur);
    if constexpr (SP2) {
        PG8_STAGE(PG8_SB(0, 0), cB, voffB); PG8_STAGE(PG8_SB(0, 1), cB + hstep, voffB); PG8_STAGE(PG8_SA(0, 0), cA, voffA); PG8_STAGE(PG8_SA(0, 1), cA + hstep, voffA);
        if (wr == 1) PG8_BAR;
        PG8_WAIT_V(2); PG8_BAR;
        PG8_STAGE(PG8_SB(1, 0), cB + kstep, voffB); PG8_STAGE(PG8_SA(1, 0), cA + kstep, voffA); PG8_STAGE(PG8_SB(1, 1), cB + hstep + kstep, voffB);
        PG8_WAIT_V(6); PG8_BAR;
    } else {
        PG8_STAGE(PG8_SB(0, 0), cB, voffB); PG8_STAGE(PG8_SA(0, 0), cA, voffA); PG8_STAGE(PG8_SB(0, 1), cB + hstep, voffB); PG8_STAGE(PG8_SA(0, 1), cA + hstep, voffA);
        if (wr == 1) PG8_BAR;
        PG8_WAIT_V(4); PG8_BAR;
        PG8_STAGE(PG8_SB(1, 0), cB + kstep, voffB); PG8_STAGE(PG8_SA(1, 0), cA + kstep, voffA); PG8_STAGE(PG8_SB(1, 1), cB + hstep + kstep, voffB);
        PG8_WAIT_V(6); PG8_BAR;
    }
    for (;;) {
        const bool has_next = S.next(ui + 1, nxt);
        const char* nA = has_next ? (const char*)g.A + (size_t)nxt.pm * tstep : cA; const char* nB = has_next ? (const char*)g.Bt + (size_t)nxt.pn * tstep : cB;
        for (int t = 0; t < nt; t += 2) {
            const bool last = (t == nt - 2);
            const char* a1 = cA + (size_t)(t + 1) * kstep;
            const char* a2 = last ? nA : cA + (size_t)(t + 2) * kstep; const char* b2 = last ? nB : cB + (size_t)(t + 2) * kstep;
            const char* a3 = a2 + kstep; const char* b3 = b2 + kstep;
            if (last && has_next) S.a_ready(nxt);
            if constexpr (SP2) {
            PG8_LDB(B0, 0, 0); PG8_LDB(B1, 0, 1); PG8_SCHED; PG8_LDA(At, 0, 0); PG8_STAGE(PG8_SA(1, 1), a1 + hstep, voffA);
            PG8_WAIT_V(8); PG8_WAIT_L(0); PG8_BAR; PG8_MMA(0, 0, At, B0); PG8_MMA(0, 1, At, B1); PG8_BAR; PG8_SCHED;
            PG8_LDA(At, 0, 1); PG8_STAGE(PG8_SB(0, 0), b2, voffB); PG8_STAGE(PG8_SB(0, 1), b2 + hstep, voffB); PG8_STAGE(PG8_SA(0, 0), a2, voffA);
            PG8_WAIT_V(8); PG8_WAIT_L(0); PG8_BAR; PG8_MMA(1, 0, At, B0); PG8_MMA(1, 1, At, B1); PG8_BAR; PG8_SCHED;
            PG8_LDB(B0, 1, 0); PG8_LDB(B1, 1, 1); PG8_SCHED; PG8_LDA(At, 1, 0); PG8_STAGE(PG8_SA(0, 1), a2 + hstep, voffA);
            PG8_WAIT_V(8); PG8_WAIT_L(0); PG8_BAR; PG8_MMA(0, 0, At, B0); PG8_MMA(0, 1, At, B1); PG8_BAR; PG8_SCHED;
            PG8_LDA(At, 1, 1); PG8_STAGE(PG8_SB(1, 0), b3, voffB); PG8_STAGE(PG8_SB(1, 1), b3 + hstep, voffB); PG8_STAGE(PG8_SA(1, 0), a3, voffA);
            PG8_WAIT_V(8); PG8_WAIT_L(0); PG8_BAR; PG8_MMA(1, 0, At, B0); PG8_MMA(1, 1, At, B1); PG8_BAR; PG8_SCHED;
            } else {
            PG8_LDB(B0, 0, 0); PG8_SCHED; PG8_LDA(At, 0, 0); PG8_STAGE(PG8_SA(1, 1), a1 + hstep, voffA);
            PG8_WAIT_L(8); PG8_BAR; PG8_WAIT_L(0); PG8_MMA(0, 0, At, B0); PG8_BAR; PG8_SCHED;
            PG8_LDB(B1, 0, 1); PG8_STAGE(PG8_SB(0, 0), b2, voffB);
            PG8_BAR; PG8_WAIT_L(0); PG8_MMA(0, 1, At, B1); PG8_BAR;
            PG8_LDA(At, 0, 1); PG8_STAGE(PG8_SA(0, 0), a2, voffA);
            PG8_BAR; PG8_WAIT_L(0); PG8_MMA(1, 0, At, B0); PG8_BAR; PG8_SCHED;
            PG8_STAGE(PG8_SB(0, 1), b2 + hstep, voffB);
            PG8_WAIT_V(6); PG8_BAR; PG8_MMA(1, 1, At, B1); PG8_BAR;
            PG8_LDB(B0, 1, 0); PG8_SCHED; PG8_LDA(At, 1, 0); PG8_STAGE(PG8_SA(0, 1), a2 + hstep, voffA);
            PG8_WAIT_L(8); PG8_BAR; PG8_WAIT_L(0); PG8_MMA(0, 0, At, B0); PG8_BAR; PG8_SCHED;
            PG8_LDB(B1, 1, 1); PG8_STAGE(PG8_SB(1, 0), b3, voffB);
            PG8_BAR; PG8_WAIT_L(0); PG8_MMA(0, 1, At, B1); PG8_BAR;
            PG8_LDA(At, 1, 1); PG8_STAGE(PG8_SA(1, 0), a3, voffA);
            PG8_BAR; PG8_WAIT_L(0); PG8_MMA(1, 0, At, B0); PG8_BAR; PG8_SCHED;
            PG8_STAGE(PG8_SB(1, 1), b3 + hstep, voffB);
            PG8_WAIT_V(6); PG8_BAR; PG8_MMA(1, 1, At, B1); PG8_BAR;
            }
        }
        if constexpr (ALIGN_EPI) { if (wr == 0) PG8_BAR; }
        if constexpr (!Epi::AFTER_DRAIN) { E(acc, cur, wr, wc, fr, fq); S.done(cur); }
        if (!has_next) break;
#pragma unroll
        for (int a = 0; a < 2; ++a)
#pragma unroll
            for (int b = 0; b < 2; ++b)
#pragma unroll
                for (int m = 0; m < 4; ++m)
#pragma unroll
                    for (int n = 0; n < 2; ++n) acc[a][b][m][n] = (f32x4){0.f, 0.f, 0.f, 0.f};
        cur = nxt; cA = nA; cB = nB; ++ui;
        if constexpr (ALIGN_EPI) { if (wr == 1) PG8_BAR; }
    }
    PG8_WAIT_V(0);
    if constexpr (!ALIGN_EPI) { if (wr == 0) PG8_BAR; }
    PG8_BAR;
    if constexpr (Epi::AFTER_DRAIN) { E.fused(acc, cur, wr, wc, fr, fq, lds, wid, lane); S.done(cur); }
#undef PG8_SA
#undef PG8_SB
#undef PG8_STAGE
#undef PG8_LDA
#undef PG8_LDB
#undef PG8_MMA
#undef PG8_WAIT_V
#undef PG8_WAIT_L
#undef PG8_BAR
#undef PG8_SCHED
}
}
#define LAS __attribute__((address_space(3)))
typedef unsigned short bf16;
typedef unsigned v4u __attribute__((ext_vector_type(4)));
typedef unsigned v2u __attribute__((ext_vector_type(2)));
typedef float f32x4 __attribute__((ext_vector_type(4)));
typedef short s16x8 __attribute__((ext_vector_type(8)));
typedef short s16x4 __attribute__((ext_vector_type(4)));

constexpr int NB = 8, SEQ = 2048, DM = 2048, NTOK = NB * SEQ, FF = 5632, NWAVES = 8;
constexpr int DOWN_N = 1088, DOWN_NP = 1280;
constexpr float EPS = 1e-6f;
constexpr float LOG2E = 1.4426950408889634f, LN2 = 0.6931471805599453f;
constexpr float QSCALE_MLA = 0.07216878364870322f * LOG2E;
constexpr float QSCALE_DIL = 0.08838834764831845f * LOG2E;
constexpr int LDS_BYTES = 147456;

constexpr size_t MiB = (size_t)1 << 20;
constexpr size_t WS_WQKV = 0, WS_WD = 0, WS_WUQ = 8 * MiB, WS_WUKV = 12 * MiB, WS_WO = 72 * MiB, WS_WGU = 80 * MiB, WS_WDN = 124 * MiB;
constexpr size_t WS_BAR = 146 * MiB;
constexpr int MISC_OFF = 131072 + 320, EX_OFF = 131072 + 1024;
constexpr size_t WS_SS = 279 * MiB;
constexpr size_t WS_MTAB = 277 * MiB;
constexpr size_t WS_H = 148 * MiB, WS_O = 212 * MiB, WS_LSE = 276 * MiB;
constexpr size_t WS_DOWN = 280 * MiB, WS_CQ = 320 * MiB, WS_CKV = 336 * MiB, WS_KROPE = 352 * MiB, WS_QRAW = 356 * MiB, WS_KVRAW = 452 * MiB;
constexpr size_t WS_COST = 280 * MiB, WS_SINT = 284 * MiB;
constexpr size_t WS_A = 356 * MiB, WS_QKVG = 356 * MiB, WS_END = 580 * MiB;

struct Params { const void* in[19]; float* out; unsigned char* ws; };

__device__ __forceinline__ unsigned f2bf(float f) { unsigned u = __builtin_bit_cast(unsigned, f); return (u + 0x7fffu + ((u >> 16) & 1u)) >> 16; }
__device__ __forceinline__ unsigned pk2(float lo, float hi) { unsigned r; asm("v_cvt_pk_bf16_f32 %0, %1, %2" : "=v"(r) : "v"(lo), "v"(hi)); return r; }
__device__ __forceinline__ float bf2f(unsigned u) { return __builtin_bit_cast(float, u << 16); }
__device__ __forceinline__ float shfl_xor_l(float v, int o) { int l = (int)__builtin_amdgcn_mbcnt_hi(~0u, __builtin_amdgcn_mbcnt_lo(~0u, 0u)); asm volatile("" : "+v"(l));
    return __builtin_bit_cast(float, __builtin_amdgcn_ds_bpermute((l ^ o) << 2, __builtin_bit_cast(int, v))); }
__device__ __forceinline__ float wave_sum(float v) {
#pragma unroll
    for (int o = 1; o < 64; o <<= 1) v += shfl_xor_l(v, o);
    return v;
}
#define LDS_WAIT() asm volatile("s_waitcnt lgkmcnt(0)" ::: "memory")
__device__ __forceinline__ void swap16(float& a, float& b) { asm volatile("s_nop 1\n\tv_permlane16_swap_b32 %0, %1" : "+v"(a), "+v"(b)); }
__device__ __forceinline__ void swap32(float& a, float& b) { asm volatile("s_nop 1\n\tv_permlane32_swap_b32 %0, %1" : "+v"(a), "+v"(b)); }
__device__ __forceinline__ float xmax4(float x) { float a = x, b = x; swap16(a, b); a = fmaxf(a, b); b = a; swap32(a, b); return fmaxf(a, b); }
__device__ __forceinline__ float xsum4(float x) { float a = x, b = x; swap16(a, b); a = a + b; b = a; swap32(a, b); return a + b; }

template <bool QKPERM, bool GAIN> __device__ __forceinline__ void tr_item(const float* W, int K, int N, bf16* WT, int k0, int n0, int dst_row0, LAS float* scr, int lane, int dbase, const float* kgain) {
    float wv[32];
#pragma unroll
    for (int i = 0; i < 32; ++i) { const int kk = 2 * i + (lane >> 5); wv[i] = W[(size_t)(k0 + kk) * N + n0 + (lane & 31)]; }
#pragma unroll
    for (int i = 0; i < 32; ++i) { const int kk = 2 * i + (lane >> 5); scr[kk * 33 + (lane & 31)] = GAIN ? wv[i] * kgain[k0 + kk] : wv[i]; }
    LDS_WAIT();
    const int c = lane & 7;
#pragma unroll
    for (int j = 0; j < 4; ++j) { const int n = (lane >> 3) + 8 * j; const LAS float* s = scr + (8 * c) * 33 + n;
        v4u o; o.x = pk2(s[0 * 33], s[1 * 33]); o.y = pk2(s[2 * 33], s[3 * 33]); o.z = pk2(s[4 * 33], s[5 * 33]); o.w = pk2(s[6 * 33], s[7 * 33]);
        int rown = dst_row0 + n; if (QKPERM) { const int d = dbase + n, r = d & 63; rown = dst_row0 + 32 * (r >> 4) + 8 * ((r >> 2) & 3) + 4 * (d >> 6) + (d & 3); }
        *(v4u*)(WT + (size_t)rown * K + k0 + 8 * c) = o; }
    LDS_WAIT();
}
template <int MAP, bool GAIN = false> __device__ __forceinline__ void conv_matrix(const float* W, int K, int N, bf16* WT, int which, LAS float* scr, int gw, int ngw, int lane, const float* kgain = nullptr) {
    const int nblk = N / 32, items = (K / 64) * nblk;
    for (int it = gw; it < items; it += ngw) {
        const int kb = it / nblk, nb = it - kb * nblk, n0 = 32 * nb;
        int dst = n0;
        if (MAP == 1) dst = 256 * (n0 >> 7) + 128 * which + (n0 & 127);
        if (MAP == 2) { const int w = n0 / 6144, rem = n0 - w * 6144, g = rem >> 11, hd = rem & 2047; dst = g * 6144 + w * 2048 + hd;
            if (w < 2) { tr_item<true, GAIN>(W, K, N, WT, 64 * kb, n0, dst - (hd & 127), scr, lane, hd & 127, kgain); continue; } }
        tr_item<false, GAIN>(W, K, N, WT, 64 * kb, n0, dst, scr, lane, 0, kgain);
    }
}
__device__ __forceinline__ void norm_rows(const float* xin, const float* gain, bf16* H, int gw, int ngw, int lane) {
    for (int row = gw; row < NTOK; row += ngw) {
        const f32x4* xr = (const f32x4*)(xin + (size_t)row * DM) + lane;
        const f32x4* gr = (const f32x4*)gain + lane;
        f32x4 v[8]; float s = 0.f;
#pragma unroll
        for (int j = 0; j < 8; ++j) { v[j] = xr[64 * j]; s += (v[j].x * v[j].x + v[j].y * v[j].y) + (v[j].z * v[j].z + v[j].w * v[j].w); }
        const float rstd = rsqrtf(wave_sum(s) * (1.f / DM) + EPS);
        v2u* o8 = (v2u*)(H + (size_t)row * DM) + lane;
#pragma unroll
        for (int j = 0; j < 8; ++j) { const f32x4 g = gr[64 * j]; v2u w; w.x = pk2(v[j].x * rstd * g.x, v[j].y * rstd * g.y); w.y = pk2(v[j].z * rstd * g.z, v[j].w * rstd * g.w); o8[64 * j] = w; }
    }
}

struct AttnArgs {
    const bf16* q; long qp;
    const bf16* k; long kp;
    const bf16* k2; long k2p;
    const bf16* v; long vp;
    bf16* o; long op;
    float* lse; long lsep;
    const unsigned* qtab; const float* qgain;
    int cstart, nt, W, mode;
};
typedef short v4i16_t __attribute__((ext_vector_type(4)));
__device__ __forceinline__ s16x4 vtr(LAS const unsigned char* p) { return __builtin_bit_cast(s16x4, __builtin_amdgcn_ds_read_tr16_b64_v4i16((LAS v4i16_t*)p)); }

template <int DK, int RB, bool QPF, bool QN, class Sched>
__device__ __forceinline__ void attn_phase(LAS unsigned char* lds, const Sched& S, int tid, int wave, int lane) {
    constexpr int KS = DK / 32, KPB = DK * 2 + 16, NKL = (DK == 192) ? 3 : 2, VPB = 288, KOFF = 0, VOFF = 32768;
    const int fr = lane & 15, fq = lane >> 4;
    AttnArgs a, nx;
    bool has = S.get(0, a);
    if (!has) return;
    unsigned koff[NKL], voff[2], kdst[NKL], vdst[2];
#pragma unroll
    for (int p = 0; p < 2; ++p) { const int id = tid + 512 * p, row = id >> 4, ch = id & 15;
        koff[p] = (unsigned)(row * (int)a.kp + ch * 8) * 2u; kdst[p] = KOFF + row * KPB + ch * 16; voff[p] = (unsigned)(row * (int)a.vp + ch * 8) * 2u; vdst[p] = VOFF + row * VPB + ch * 16; }
    if (DK == 192) { const int row = tid >> 3, ch = tid & 7; koff[NKL - 1] = (unsigned)(row * (int)a.k2p + ch * 8) * 2u; kdst[NKL - 1] = KOFF + row * KPB + 256 + ch * 16; }
    const long kstep = 128 * a.kp, k2step = 128 * a.k2p, vstep = 128 * a.vp;
    const char* ktile; const char* k2tile = nullptr; const char* vtile;
    v4u kreg[NKL], vreg[2];
    s16x8 qn[QPF ? RB : 1][KS];
#define ATT_BASE(A) do { ktile = (const char*)((A).k + (long)(A).cstart * (A).kp); if (DK == 192) k2tile = (const char*)((A).k2 + (long)(A).cstart * (A).k2p); vtile = (const char*)((A).v + (long)(A).cstart * (A).vp); } while (0)
#define ATT_LOAD() do { \
        kreg[0] = *(const v4u*)(ktile + koff[0]); kreg[1] = *(const v4u*)(ktile + koff[1]); if (DK == 192) kreg[NKL - 1] = *(const v4u*)(k2tile + koff[NKL - 1]); \
        vreg[0] = *(const v4u*)(vtile + voff[0]); vreg[1] = *(const v4u*)(vtile + voff[1]); ktile += kstep; vtile += vstep; if (DK == 192) k2tile += k2step; } while (0)
#define ATT_QLOAD(DST, A) do { _Pragma("unroll") for (int rb_ = 0; rb_ < RB; ++rb_) { const bf16* qrow_ = (A).q + (long)(wave * 16 * RB + rb_ * 16 + fr) * (A).qp + fq * 8; \
        _Pragma("unroll") for (int ks_ = 0; ks_ < KS; ++ks_) DST[rb_][ks_] = *(const s16x8*)(qrow_ + ks_ * 32); } } while (0)
    if (QPF) ATT_QLOAD(qn, a);
    ATT_BASE(a); ATT_LOAD();
    const int w_lo = wave * 16 * RB, w_hi = w_lo + 16 * RB - 1;
    for (int ui = 0; has; ++ui) {
        const bool hasn = S.get(ui + 1, nx);
        s16x8 qf[RB][KS];
        if (QPF) {
#pragma unroll
            for (int rb = 0; rb < RB; ++rb)
#pragma unroll
                for (int ks = 0; ks < KS; ++ks) qf[rb][ks] = qn[rb][ks];
        } else ATT_QLOAD(qf, a);
        if (QN) {
#pragma unroll
            for (int rb = 0; rb < RB; ++rb) {
                const unsigned* tr = a.qtab + (size_t)(w_lo + rb * 16 + fr) * 32 + fq * 8;
                const v4u t0 = *(const v4u*)tr, t1 = *(const v4u*)(tr + 4);
                float x[KS][8]; float ssn = 0.f, ssr = 0.f;
#pragma unroll
                for (int ks = 0; ks < KS; ++ks)
#pragma unroll
                    for (int e = 0; e < 8; ++e) { x[ks][e] = bf2f((unsigned short)qf[rb][ks][e]); if (ks < 4) ssn += x[ks][e] * x[ks][e]; else ssr += x[ks][e] * x[ks][e]; }
                ssn = xsum4(ssn); ssr = xsum4(ssr);
                const float rn = rsqrtf(ssn * (1.f / 128) + EPS) * QSCALE_MLA, rr = rsqrtf(ssr * (1.f / 64) + EPS);
#pragma unroll
                for (int ks = 0; ks < 4; ++ks) { const f32x4 g0 = *(const f32x4*)(a.qgain + ks * 32 + fq * 8), g1 = *(const f32x4*)(a.qgain + ks * 32 + fq * 8 + 4);
                    v4u w; w.x = pk2(x[ks][0] * rn * g0.x, x[ks][1] * rn * g0.y); w.y = pk2(x[ks][2] * rn * g0.z, x[ks][3] * rn * g0.w); w.z = pk2(x[ks][4] * rn * g1.x, x[ks][5] * rn * g1.y); w.w = pk2(x[ks][6] * rn * g1.z, x[ks][7] * rn * g1.w);
                    qf[rb][ks] = __builtin_bit_cast(s16x8, w); }
                { const f32x4 ga0 = *(const f32x4*)(a.qgain + 128 + fq * 8), ga1 = *(const f32x4*)(a.qgain + 132 + fq * 8), gb0 = *(const f32x4*)(a.qgain + 160 + fq * 8), gb1 = *(const f32x4*)(a.qgain + 164 + fq * 8);
                  const float gA[8] = {ga0.x, ga0.y, ga0.z, ga0.w, ga1.x, ga1.y, ga1.z, ga1.w}, gB[8] = {gb0.x, gb0.y, gb0.z, gb0.w, gb1.x, gb1.y, gb1.z, gb1.w};
                  const unsigned tw[8] = {t0.x, t0.y, t0.z, t0.w, t1.x, t1.y, t1.z, t1.w};
                  float o1[8], o2[8];
#pragma unroll
                  for (int e = 0; e < 8; ++e) { const float cs = (float)((int)(tw[e] << 16) >> 16) * (1.f / 32767.f), sn = (float)((int)tw[e] >> 16) * (1.f / 32767.f);
                      const float y1 = x[4][e] * rr * gA[e], y2 = x[5][e] * rr * gB[e]; o1[e] = (y1 * cs - y2 * sn) * QSCALE_MLA; o2[e] = (y2 * cs + y1 * sn) * QSCALE_MLA; }
                  v4u w1, w2; w1.x = pk2(o1[0], o1[1]); w1.y = pk2(o1[2], o1[3]); w1.z = pk2(o1[4], o1[5]); w1.w = pk2(o1[6], o1[7]); w2.x = pk2(o2[0], o2[1]); w2.y = pk2(o2[2], o2[3]); w2.z = pk2(o2[4], o2[5]); w2.w = pk2(o2[6], o2[7]);
                  qf[rb][4] = __builtin_bit_cast(s16x8, w1); qf[rb][5] = __builtin_bit_cast(s16x8, w2); }
            }
        }
        v2u oldo[RB][8]; float oldl[RB];
        if (a.mode == 2) {
#pragma unroll
            for (int rb = 0; rb < RB; ++rb) { const int iq = w_lo + rb * 16 + fr; const bf16* orow = a.o + (long)iq * a.op + fq * 4; oldl[rb] = a.lse[(long)iq * a.lsep];
#pragma unroll
                for (int db = 0; db < 8; ++db) oldo[rb][db] = *(const v2u*)(orow + db * 16); }
        }
        f32x4 o[RB][8];
        float m[RB], l[RB];
#pragma unroll
        for (int rb = 0; rb < RB; ++rb) { m[rb] = -1e30f; l[rb] = 0.f;
#pragma unroll
            for (int db = 0; db < 8; ++db) o[rb][db] = (f32x4){0.f, 0.f, 0.f, 0.f}; }
        for (int t = 0; t < a.nt; ++t) {
            __syncthreads();
#pragma unroll
            for (int p = 0; p < NKL; ++p) *(LAS v4u*)(lds + kdst[p]) = kreg[p];
#pragma unroll
            for (int p = 0; p < 2; ++p) *(LAS v4u*)(lds + vdst[p]) = vreg[p];
            __syncthreads();
            if (t + 1 < a.nt) ATT_LOAD();
            else if (hasn) { if (QPF) ATT_QLOAD(qn, nx); ATT_BASE(nx); ATT_LOAD(); }
            const int ct = a.cstart + 64 * t;
            const bool needed = (ct <= w_hi) && (ct + 63 >= w_lo - a.W);
            if (needed) {
                f32x4 s[RB][4];
#pragma unroll
                for (int kb = 0; kb < 4; ++kb) {
#pragma unroll
                    for (int rb = 0; rb < RB; ++rb) s[rb][kb] = (f32x4){0.f, 0.f, 0.f, 0.f};
                    const int row = kb * 16 + fr;
                    LAS const unsigned char* kp = lds + KOFF + row * KPB + fq * 16;
#pragma unroll
                    for (int ks = 0; ks < KS; ++ks) { const s16x8 kf = *(LAS const s16x8*)(kp + ks * 64);
#pragma unroll
                        for (int rb = 0; rb < RB; ++rb) s[rb][kb] = __builtin_amdgcn_mfma_f32_16x16x32_bf16(kf, qf[rb][ks], s[rb][kb], 0, 0, 0); }
                }
                s16x8 pf[RB][2];
#pragma unroll
                for (int rb = 0; rb < RB; ++rb) {
                    const int i_lo = w_lo + rb * 16, i_hi = i_lo + 15, iq = i_lo + fr;
                    const bool full = (ct + 63 <= i_lo) && (ct >= i_hi - a.W);
                    if (!full) {
#pragma unroll
                        for (int kb = 0; kb < 4; ++kb)
#pragma unroll
                            for (int j = 0; j < 4; ++j) { const int c = ct + kb * 16 + fq * 4 + j; const bool ok = (c <= iq) && (c >= iq - a.W); s[rb][kb][j] = ok ? s[rb][kb][j] : -1e30f; }
                    }
                    float mx = fmaxf(fmaxf(fmaxf(s[rb][0][0], s[rb][0][1]), fmaxf(s[rb][0][2], s[rb][0][3])), fmaxf(fmaxf(s[rb][1][0], s[rb][1][1]), fmaxf(s[rb][1][2], s[rb][1][3])));
                    mx = fmaxf(mx, fmaxf(fmaxf(fmaxf(s[rb][2][0], s[rb][2][1]), fmaxf(s[rb][2][2], s[rb][2][3])), fmaxf(fmaxf(s[rb][3][0], s[rb][3][1]), fmaxf(s[rb][3][2], s[rb][3][3]))));
                    mx = xmax4(mx);
                    const float mn = fmaxf(m[rb], mx), alpha = __builtin_amdgcn_exp2f(m[rb] - mn);
                    m[rb] = mn;
                    float ps = 0.f;
#pragma unroll
                    for (int kb = 0; kb < 4; ++kb)
#pragma unroll
                        for (int j = 0; j < 4; ++j) { s[rb][kb][j] = __builtin_amdgcn_exp2f(s[rb][kb][j] - mn); ps += s[rb][kb][j]; }
                    l[rb] = l[rb] * alpha + ps;
                    if (__builtin_amdgcn_ballot_w64(alpha != 1.f) != 0ull) {
#pragma unroll
                        for (int db = 0; db < 8; ++db) o[rb][db] = o[rb][db] * alpha; }
#pragma unroll
                    for (int h2 = 0; h2 < 2; ++h2) { v4u w; w.x = pk2(s[rb][2 * h2][0], s[rb][2 * h2][1]); w.y = pk2(s[rb][2 * h2][2], s[rb][2 * h2][3]); w.z = pk2(s[rb][2 * h2 + 1][0], s[rb][2 * h2 + 1][1]); w.w = pk2(s[rb][2 * h2 + 1][2], s[rb][2 * h2 + 1][3]);
                        pf[rb][h2] = __builtin_bit_cast(s16x8, w); }
                }
#pragma unroll
                for (int db = 0; db < 8; ++db)
#pragma unroll
                    for (int h2 = 0; h2 < 2; ++h2) {
                        LAS const unsigned char* vp = lds + VOFF + (h2 * 32 + fq * 4 + (fr >> 2)) * VPB + (db * 16 + (fr & 3) * 4) * 2;
                        const s16x4 lo = vtr(vp), hi = vtr(vp + 16 * VPB);
                        const s16x8 vf = {lo[0], lo[1], lo[2], lo[3], hi[0], hi[1], hi[2], hi[3]};
#pragma unroll
                        for (int rb = 0; rb < RB; ++rb) o[rb][db] = __builtin_amdgcn_mfma_f32_16x16x32_bf16(vf, pf[rb][h2], o[rb][db], 0, 0, 0);
                    }
            }
        }
#pragma unroll
        for (int rb = 0; rb < RB; ++rb) {
            const int iq = w_lo + rb * 16 + fr;
            const float lt = xsum4(l[rb]);
            const float inv = 1.f / lt;
            bf16* orow = a.o + (long)iq * a.op + fq * 4;
            if (a.mode == 0) {
#pragma unroll
                for (int db = 0; db < 8; ++db) { v2u w; w.x = pk2(o[rb][db][0] * inv, o[rb][db][1] * inv); w.y = pk2(o[rb][db][2] * inv, o[rb][db][3] * inv); *(v2u*)(orow + db * 16) = w; }
            } else {
                float* lp = a.lse + (long)iq * a.lsep;
                float lse = m[rb] * LN2 + __logf(lt);
                float wn = inv, wo = 0.f;
                if (a.mode == 2) { const float lo = oldl[rb], mm = fmaxf(lo, lse), eo = __expf(lo - mm), en = __expf(lse - mm), den = eo + en; wo = eo / den; wn = en / den * inv; lse = mm + __logf(den); }
#pragma unroll
                for (int db = 0; db < 8; ++db) {
                    float r0 = o[rb][db][0] * wn, r1 = o[rb][db][1] * wn, r2 = o[rb][db][2] * wn, r3 = o[rb][db][3] * wn;
                    if (a.mode == 2) { const v2u old = oldo[rb][db]; r0 += wo * bf2f(old.x & 0xffffu); r1 += wo * bf2f(old.x >> 16); r2 += wo * bf2f(old.y & 0xffffu); r3 += wo * bf2f(old.y >> 16); }
                    v2u w; w.x = pk2(r0, r1); w.y = pk2(r2, r3); *(v2u*)(orow + db * 16) = w;
                }
                if (fq == 0) *lp = lse;
            }
        }
        a = nx; has = hasn;
    }
#undef ATT_LOAD
#undef ATT_BASE
#undef ATT_QLOAD
}
#define XB_TMO      128
#define XB_XCNT(j)  (256  + 64 * (j))
#define XB_XSUB(j)  (1280 + 64 * (j))
#define XB_XGEN(j)  (2304 + 64 * (j))
#define XB_TOP      3328
#define XB_TOPGEN   3392
#define XCD_BAR_WORDS 3456
#define XB_SPIN_CAP (1u << 18)

__device__ __forceinline__ unsigned xb_ld(unsigned* p)              { return __hip_atomic_load(p, __ATOMIC_RELAXED, __HIP_MEMORY_SCOPE_AGENT); }
__device__ __forceinline__ unsigned xb_add(unsigned* p, unsigned v) { return __hip_atomic_fetch_add(p, v, __ATOMIC_RELAXED, __HIP_MEMORY_SCOPE_AGENT); }
__device__ __forceinline__ unsigned xb_xcc_id() { return (unsigned)__builtin_amdgcn_s_getreg((3 << 11) | 20) & 0xFu; }
#define XB_SPIN(cond, bar) do { unsigned _sp = 0; while (cond) { __builtin_amdgcn_s_sleep(1); \
    if ((++_sp & 255u) == 0u) { if (xb_ld(&(bar)[XB_TMO])) break; if (_sp > XB_SPIN_CAP) { atomicAdd(&(bar)[XB_TMO], 1u); break; } } } } while (0)

struct XcdBarrier {
    unsigned* bar; unsigned x;
    volatile LAS unsigned* st;
};

__device__ __forceinline__ XcdBarrier xcd_barrier_post(unsigned* bar, volatile LAS unsigned* st) {
    XcdBarrier b; b.bar = bar; b.x = xb_xcc_id(); b.st = st;
    if (threadIdx.x == 0) (void)xb_add(&bar[XB_XCNT(b.x)], 1u);
    return b;
}
__device__ __forceinline__ void xcd_barrier_complete(unsigned* bar, unsigned x, unsigned& nloc, unsigned& nx) {
    const unsigned G = gridDim.x * gridDim.y * gridDim.z;
    unsigned sum, cnt, mine, sp = 0u;
    for (;;) {
        sum = 0u; cnt = 0u; mine = 0u;
#pragma unroll
        for (unsigned j = 0; j < 16; ++j) { const unsigned c = xb_ld(&bar[XB_XCNT(j)]); sum += c; cnt += (c > 0u) ? 1u : 0u; mine = (j == x) ? c : mine; }
        if (sum == G) break;
        __builtin_amdgcn_s_sleep(1);
        if ((++sp & 255u) == 0u) { if (xb_ld(&bar[XB_TMO])) break; if (sp > XB_SPIN_CAP) { atomicAdd(&bar[XB_TMO], 1u); break; } }
    }
    nloc = mine > 0u ? mine : 1u; nx = cnt > 0u ? cnt : 1u;
}

__device__ __forceinline__ void xcd_barrier(const XcdBarrier& b) {
    asm volatile("s_waitcnt vmcnt(0)" ::: "memory");
    __syncthreads();
    if (threadIdx.x == 0) {
        unsigned* bar = b.bar;
        __builtin_amdgcn_s_waitcnt(0);
        unsigned nloc = b.st[0], nx = b.st[1];
        if (nloc == 0u) { xcd_barrier_complete(bar, b.x, nloc, nx); b.st[0] = nloc; b.st[1] = nx; }
        const unsigned old = xb_add(&bar[XB_XSUB(b.x)], 1u);
        const unsigned gen = old / nloc;
        if (old + 1u == (gen + 1u) * nloc) {
            __builtin_amdgcn_fence(__ATOMIC_RELEASE, "agent");
            asm volatile("s_waitcnt vmcnt(0)" ::: "memory");
            const unsigned og = xb_add(&bar[XB_TOP], 1u);
            const unsigned tg = og / nx;
            if (og + 1u == (tg + 1u) * nx) xb_add(&bar[XB_TOPGEN], 1u);
            else XB_SPIN(xb_ld(&bar[XB_TOPGEN]) == tg, bar);
            __builtin_amdgcn_fence(__ATOMIC_ACQUIRE, "agent");
            xb_add(&bar[XB_XGEN(b.x)], 1u);
            asm volatile("s_waitcnt vmcnt(0)" ::: "memory");
        } else {
            XB_SPIN(xb_ld(&bar[XB_XGEN(b.x)]) == gen, bar);
            __builtin_amdgcn_fence(__ATOMIC_ACQUIRE, "agent");
            asm volatile("s_waitcnt vmcnt(0)" ::: "memory");
        }
    }
    __syncthreads();
}
template <class Epi, bool ALIGN = true, int WGMV = 4> __device__ __forceinline__ void run_gemm(LAS unsigned char* lds, const bf16* A, const bf16* Bt, int M, int N, int K, const Epi& E) {
    pg8::Gemm g{A, Bt, M, N, K}; pg8::StaticOrder S; S.init(M, N, (int)gridDim.x, (int)blockIdx.x, WGMV);
    pg8::gemm_phase<Epi, pg8::StaticOrder, ALIGN, true>(lds, g, S, E);
}


#define GAS __attribute__((address_space(1)))
__device__ __forceinline__ void* karg(int i) { typedef void* const volatile __attribute__((address_space(4))) * kargp_t; kargp_t ka = (kargp_t)__builtin_amdgcn_kernarg_segment_ptr(); void* q = ka[i]; return (void*)(GAS void*)q; }
#define INF(i) ((const float*)karg(i))
#define WSB(off) ((bf16*)((unsigned char*)karg(20) + (off)))
#define P_x INF(0)
#define P_positions ((const int*)karg(1))
#define P_mixer_norm INF(2)
#define P_ffn_norm INF(3)
#define P_mla_w_down INF(4)
#define P_mla_q_norm INF(5)
#define P_mla_kv_norm INF(6)
#define P_mla_w_uq INF(7)
#define P_mla_w_ukv INF(8)
#define P_mla_q_gain INF(9)
#define P_mla_k_gain INF(10)
#define P_mla_w_o INF(11)
#define P_dil_w_qkv INF(12)
#define P_dil_q_gain INF(13)
#define P_dil_k_gain INF(14)
#define P_dil_w_o INF(15)
#define P_ffn_w_gate INF(16)
#define P_ffn_w_up INF(17)
#define P_ffn_w_down INF(18)
#define P_out ((float*)karg(19))
#define P_Wqkv_t WSB(WS_WQKV)
#define P_Wd_t WSB(WS_WD)
#define P_Wuq_t WSB(WS_WUQ)
#define P_Wukv_t WSB(WS_WUKV)
#define P_Wo_t WSB(WS_WO)
#define P_Wgu_t WSB(WS_WGU)
#define P_Wdn_t WSB(WS_WDN)
#define P_H WSB(WS_H)
#define P_O WSB(WS_O)
#define P_LSE ((float*)WSB(WS_LSE))
#define P_DOWN WSB(WS_DOWN)
#define P_CQ WSB(WS_CQ)
#define P_CKV WSB(WS_CKV)
#define P_KROPE WSB(WS_KROPE)
#define P_QRAW WSB(WS_QRAW)
#define P_KVRAW WSB(WS_KVRAW)
#define P_ACT WSB(WS_A)
#define P_QKVG WSB(WS_QKVG)
__global__ void __launch_bounds__(NWAVES * 64, 2) fwd_kernel(Params p) {
    extern __shared__ __attribute__((aligned(16))) unsigned char lds_raw[];
    LAS unsigned char* lds = (LAS unsigned char*)lds_raw;
#define PHASE_IDS int tid_ = threadIdx.x; asm volatile("" : "+v"(tid_)); const int tid = tid_, lane = tid & 63, wave = __builtin_amdgcn_readfirstlane(tid >> 6); \
    const int G = gridDim.x, gw = blockIdx.x * NWAVES + wave, ngw = G * NWAVES; LAS float* scr = (LAS float*)(lds + wave * 16384); (void)scr; (void)gw; (void)ngw; (void)lane; (void)G;

    if (threadIdx.x < 32) ((LAS unsigned*)(lds + MISC_OFF))[threadIdx.x] = 0u;
    __syncthreads();
    XcdBarrier xbar = xcd_barrier_post((unsigned*)((unsigned char*)karg(20) + WS_BAR), (volatile LAS unsigned*)(lds + MISC_OFF) + 8);
#define GRID_SYNC() do { XcdBarrier b_; b_.bar = (unsigned*)((unsigned char*)karg(20) + WS_BAR); b_.x = xb_xcc_id(); b_.st = (volatile LAS unsigned*)(lds + MISC_OFF) + 8; xcd_barrier(b_); } while (0)
    (void)xbar;
    for (int layer = 0; layer < 2; ++layer) {
        { PHASE_IDS
        if (layer == 0) norm_rows(P_x, P_mixer_norm, P_H, gw, ngw, lane); else norm_rows(P_out, P_mixer_norm + DM, P_H, gw, ngw, lane);
        if (layer == 0) {
            bf16* const wd_t = P_Wd_t;
            { float* const ssz = (float*)WSB(WS_SS); for (int i = blockIdx.x * 512 + tid; i < 2 * NTOK; i += G * 512) { float zz = 0.f; asm volatile("" : "+v"(zz)); ssz[i] = zz; } }
            { unsigned* const tm = (unsigned*)WSB(WS_MTAB); const int* const pos = P_positions; const float ifr = powf(10000.f, -2.f * (float)(lane & 31) / 64.f);
              for (int t2 = gw; t2 < NTOK / 2; t2 += ngw) { const int t = 2 * t2 + (lane >> 5); const float ang = (float)pos[t] * ifr; const int ci = (int)rintf(cosf(ang) * 32767.f), si = (int)rintf(sinf(ang) * 32767.f);
                  tm[(size_t)t * 32 + (lane & 31)] = ((unsigned)ci & 0xffffu) | ((unsigned)si << 16); } }
            conv_matrix<0>(P_mla_w_down, DM, DOWN_N, wd_t, 0, scr, gw, ngw, lane);
            for (int i = blockIdx.x * 512 + tid; i < (DOWN_NP - DOWN_N) * DM / 8; i += G * 512) { unsigned zz = 0u; asm volatile("" : "+v"(zz)); ((v4u*)(wd_t + (size_t)DOWN_N * DM))[i] = (v4u){zz, zz, zz, zz}; }
            conv_matrix<0>(P_mla_w_uq, 512, 3072, P_Wuq_t, 0, scr, gw, ngw, lane);
            conv_matrix<0>(P_mla_w_ukv, 512, 4096, P_Wukv_t, 0, scr, gw, ngw, lane);
        } else {
            conv_matrix<2>(P_dil_w_qkv, DM, 18432, P_Wqkv_t, 0, scr, gw, ngw, lane);
            { unsigned* const tb = (unsigned*)WSB(WS_COST); const int* const pos = P_positions; const float ifr = powf(10000.f, -2.f * (float)lane / 128.f);
              for (int t = gw; t < NTOK; t += ngw) { const float ang = (float)pos[t] * ifr; const int ci = (int)rintf(cosf(ang) * 32767.f), si = (int)rintf(sinf(ang) * 32767.f);
                  tb[(size_t)t * 64 + lane] = ((unsigned)ci & 0xffffu) | ((unsigned)si << 16); } }
            conv_matrix<0>(P_dil_w_o, DM, DM, P_Wo_t, 0, scr, gw, ngw, lane);
        }
        if (layer == 1) {
        conv_matrix<1, true>(P_ffn_w_gate + (size_t)DM * FF, DM, FF, P_Wgu_t, 0, scr, gw, ngw, lane, P_ffn_norm + DM);
        conv_matrix<1, true>(P_ffn_w_up + (size_t)DM * FF, DM, FF, P_Wgu_t, 1, scr, gw, ngw, lane, P_ffn_norm + DM);
        conv_matrix<0>(P_ffn_w_down + (size_t)DM * FF, FF, DM, P_Wdn_t, 0, scr, gw, ngw, lane);
        }
        }
        if (gridDim.x == 0x7fffffffu) cg::this_grid().sync();
        GRID_SYNC();

        if (layer == 0) {
            { pg8::EpiStoreBf16 E{P_DOWN, DOWN_NP}; run_gemm(lds, P_H, P_Wd_t, NTOK, DOWN_NP, DM, E); }
            { PHASE_IDS
              const bool shadow = (G == 256);
              if (!shadow || blockIdx.x >= 64) {
                  const int gw2 = shadow ? ((int)blockIdx.x - 64) * NWAVES + wave : gw, ngw2 = shadow ? 192 * NWAVES : ngw;
                  conv_matrix<0>(P_mla_w_o, DM, DM, P_Wo_t, 0, scr, gw2, ngw2, lane);
                  conv_matrix<1, true>(P_ffn_w_gate, DM, FF, P_Wgu_t, 0, scr, gw2, ngw2, lane, P_ffn_norm);
                  conv_matrix<1, true>(P_ffn_w_up, DM, FF, P_Wgu_t, 1, scr, gw2, ngw2, lane, P_ffn_norm);
                  conv_matrix<0>(P_ffn_w_down, FF, DM, P_Wdn_t, 0, scr, gw2, ngw2, lane);
              } }
            GRID_SYNC();
            { PHASE_IDS const bf16* const L_DOWN = P_DOWN; bf16* const L_CQ = P_CQ; bf16* const L_CKV = P_CKV; bf16* const L_KROPE = P_KROPE; const float* const L_mla_q_norm = P_mla_q_norm; const float* const L_mla_kv_norm = P_mla_kv_norm; const float* const L_mla_k_gain = P_mla_k_gain; const int* const L_positions = P_positions;
            for (int t = gw; t < NTOK; t += ngw) {
                const bf16* dr = L_DOWN + (size_t)t * DOWN_NP;
                const s16x8 a8 = *(const s16x8*)(dr + lane * 8), b8 = *(const s16x8*)(dr + 512 + lane * 8);
                const float xr = bf2f(dr[1024 + lane]);
                float fa[8], fb[8], sa = 0.f, sb = 0.f;
#pragma unroll
                for (int j = 0; j < 8; ++j) { fa[j] = bf2f((unsigned short)a8[j]); fb[j] = bf2f((unsigned short)b8[j]); sa += fa[j] * fa[j]; sb += fb[j] * fb[j]; }
                const float ra = rsqrtf(wave_sum(sa) * (1.f / 512) + EPS), rb = rsqrtf(wave_sum(sb) * (1.f / 512) + EPS), rr = rsqrtf(wave_sum(xr * xr) * (1.f / 64) + EPS);
                const f32x4 ga0 = *(const f32x4*)(L_mla_q_norm + lane * 8), ga1 = *(const f32x4*)(L_mla_q_norm + lane * 8 + 4);
                const f32x4 gb0 = *(const f32x4*)(L_mla_kv_norm + lane * 8), gb1 = *(const f32x4*)(L_mla_kv_norm + lane * 8 + 4);
                v4u wa, wb;
                wa.x = pk2(fa[0] * ra * ga0.x, fa[1] * ra * ga0.y); wa.y = pk2(fa[2] * ra * ga0.z, fa[3] * ra * ga0.w); wa.z = pk2(fa[4] * ra * ga1.x, fa[5] * ra * ga1.y); wa.w = pk2(fa[6] * ra * ga1.z, fa[7] * ra * ga1.w);
                wb.x = pk2(fb[0] * rb * gb0.x, fb[1] * rb * gb0.y); wb.y = pk2(fb[2] * rb * gb0.z, fb[3] * rb * gb0.w); wb.z = pk2(fb[4] * rb * gb1.x, fb[5] * rb * gb1.y); wb.w = pk2(fb[6] * rb * gb1.z, fb[7] * rb * gb1.w);
                *(v4u*)(L_CQ + (size_t)t * 512 + lane * 8) = wa; *(v4u*)(L_CKV + (size_t)t * 512 + lane * 8) = wb;
                const float y = xr * rr * L_mla_k_gain[128 + lane];
                const float ang = (float)L_positions[t] * powf(10000.f, -2.f * (float)(lane & 31) / 64.f);
                const float cs = cosf(ang), sn = sinf(ang), pr = shfl_xor_l(y, 32);
                L_KROPE[(size_t)t * 64 + lane] = (bf16)f2bf(lane < 32 ? y * cs - pr * sn : y * cs + pr * sn);
            } }
            GRID_SYNC();
            { pg8::EpiStoreBf16 E{P_QRAW, 3072}; run_gemm(lds, P_CQ, P_Wuq_t, NTOK, 3072, 512, E); }
            { pg8::EpiKVNorm E{P_KVRAW, 4096, P_mla_k_gain, (unsigned)(__SIZE_TYPE__)(lds + EX_OFF)}; run_gemm(lds, P_CKV, P_Wukv_t, NTOK, 4096, 512, E); }
            GRID_SYNC();
            { PHASE_IDS const bf16* const L_QRAW = P_QRAW; const bf16* const L_KVRAW = P_KVRAW; const bf16* const L_KROPE = P_KROPE; bf16* const L_O = P_O;
            struct MlaSched { const bf16* QR; const bf16* KV; const bf16* KR; bf16* OO; int c; const unsigned* TB; const float* QG;
                __device__ __forceinline__ bool get(int it, AttnArgs& a) const {
                    if (it >= 4 || c >= 256) return false;
                    const int bh = c & 127, half = (c >> 7) & 1, b = bh >> 4, h = bh & 15;
                    const int qb = half ? (it == 0 ? 6 : it == 1 ? 5 : it == 2 ? 2 : 1) : (it == 0 ? 7 : it == 1 ? 4 : it == 2 ? 3 : 0), q0 = qb * 256; const size_t tok0 = (size_t)b * SEQ + q0;
                    a.q = QR + tok0 * 3072 + h * 192; a.qp = 3072; a.k = KV + tok0 * 4096 + h * 256; a.kp = 4096; a.k2 = KR + tok0 * 64; a.k2p = 64;
                    a.v = KV + tok0 * 4096 + h * 256 + 128; a.vp = 4096; a.o = OO + tok0 * DM + h * 128; a.op = DM; a.lse = nullptr; a.lsep = 0;
                    a.cstart = -q0; a.nt = (q0 + 256) / 64; a.W = 1 << 24; a.mode = 0; a.qtab = TB + tok0 * 32; a.qgain = QG; return true; } };
            const MlaSched S{L_QRAW, L_KVRAW, L_KROPE, L_O, (int)blockIdx.x, (const unsigned*)WSB(WS_MTAB), P_mla_q_gain};
            attn_phase<192, 2, false, true, MlaSched>(lds, S, tid, wave, lane); }
            __syncthreads();
            GRID_SYNC();
        } else {
            for (int g = 0; g < 3; ++g) {
                { pg8::EpiQKRope E{P_QKVG, 6144, (const unsigned*)WSB(WS_COST), P_dil_q_gain + g * 128, P_dil_k_gain + g * 128, QSCALE_DIL, (unsigned)(__SIZE_TYPE__)(lds + EX_OFF)}; run_gemm(lds, P_H, P_Wqkv_t + (size_t)g * 6144 * DM, NTOK, 6144, DM, E); }
                GRID_SYNC();
                { PHASE_IDS const bf16* const L_QKVG = P_QKVG; bf16* const L_O = P_O; float* const L_LSE = P_LSE; const float* const L_COST = (const float*)WSB(WS_COST); const float* const L_SINT = (const float*)WSB(WS_SINT); const float* const L_dil_q_gain = P_dil_q_gain; const float* const L_dil_k_gain = P_dil_k_gain;
                struct DilSched { const bf16* QKV; bf16* OO; float* LS; int c, G, dl, nbk, mode;
                    __device__ __forceinline__ bool get(int i, AttnArgs& a) const {
                        const int u = c + i * G; if (u >= 2048) return false;
                        const int bh = u & 127, sub = u >> 7, b = bh >> 4, h = bh & 15, r = sub / nbk, blk = sub - r * nbk, i0 = blk * 128; const size_t tok0 = (size_t)b * SEQ + r + (size_t)dl * i0;
                        a.q = QKV + tok0 * 6144 + h * 128; a.qp = (long)dl * 6144; a.k = a.q + 2048; a.kp = a.qp; a.k2 = nullptr; a.k2p = 0; a.v = a.q + 4096; a.vp = a.qp;
                        a.o = OO + tok0 * DM + h * 128; a.op = (long)dl * DM; a.lse = LS + tok0 * 16 + h; a.lsep = (long)dl * 16;
                        a.cstart = blk == 0 ? 0 : -128; a.nt = blk == 0 ? 2 : 4; a.W = 128; a.mode = mode; a.qtab = nullptr; a.qgain = nullptr; return true; } };
                const int dl = (g == 0) ? 1 : (g == 1 ? 4 : 16);
                const DilSched S{L_QKVG, L_O, L_LSE, (int)blockIdx.x, G, dl, 16 / dl, g == 0 ? 1 : 2};
                attn_phase<128, 1, true, false, DilSched>(lds, S, tid, wave, lane); }
                __syncthreads();
                GRID_SYNC();
            }
        }
        { pg8::EpiResF32Stat E{layer == 0 ? P_x : P_out, P_out, DM, P_H, (float*)WSB(WS_SS) + layer * NTOK}; run_gemm(lds, P_O, P_Wo_t, NTOK, DM, DM, E); }
        GRID_SYNC();
        { pg8::EpiSwiGLU E{P_ACT, FF, (const float*)WSB(WS_SS) + layer * NTOK}; run_gemm(lds, P_H, P_Wgu_t, NTOK, 2 * FF, DM, E); }
        GRID_SYNC();
        { pg8::EpiResF32 E{P_out, P_out, DM}; run_gemm<pg8::EpiResF32, true, 2>(lds, P_ACT, P_Wdn_t, NTOK, DM, FF, E); }
        GRID_SYNC();
    }
}

#undef P_x
#undef P_positions
#undef P_mixer_norm
#undef P_ffn_norm
#undef P_mla_w_down
#undef P_mla_q_norm
#undef P_mla_kv_norm
#undef P_mla_w_uq
#undef P_mla_w_ukv
#undef P_mla_q_gain
#undef P_mla_k_gain
#undef P_mla_w_o
#undef P_dil_w_qkv
#undef P_dil_q_gain
#undef P_dil_k_gain
#undef P_dil_w_o
#undef P_ffn_w_gate
#undef P_ffn_w_up
#undef P_ffn_w_down
#undef P_out
#undef P_Wqkv_t
#undef P_Wd_t
#undef P_Wuq_t
#undef P_Wukv_t
#undef P_Wo_t
#undef P_Wgu_t
#undef P_Wdn_t
#undef P_H
#undef P_O
#undef P_LSE
#undef P_DOWN
#undef P_CQ
#undef P_CKV
#undef P_KROPE
#undef P_QRAW
#undef P_KVRAW
#undef P_ACT
#undef P_QKVG
extern "C" void kernel_launch(void* const* d_in, const int* in_sizes, int n_in, void* d_out, int out_size, void* d_ws, size_t ws_size, hipStream_t stream) {
    static int grid_blocks = 0;
    if (grid_blocks == 0) {
        if (n_in != 19 || ws_size < WS_END) { fprintf(stderr, "kernel_launch: expected 19 inputs and >= %zu bytes of workspace; got %d inputs, %zu bytes\n", (size_t)WS_END, n_in, ws_size); grid_blocks = -1; return; }
        int dev = 0, cus = 0, per_cu = 0;
        hipGetDevice(&dev);
        hipDeviceGetAttribute(&cus, hipDeviceAttributeMultiprocessorCount, dev);
        if (hipFuncSetAttribute((const void*)fwd_kernel, hipFuncAttributeMaxDynamicSharedMemorySize, LDS_BYTES) != hipSuccess) fprintf(stderr, "kernel_launch: hipFuncSetAttribute failed\n");
        if (hipOccupancyMaxActiveBlocksPerMultiprocessor(&per_cu, (const void*)fwd_kernel, NWAVES * 64, LDS_BYTES) != hipSuccess || per_cu < 1) { fprintf(stderr, "kernel_launch: occupancy query says %d blocks per CU; using 1\n", per_cu); per_cu = 1; }
        (void)hipGetLastError();
        grid_blocks = cus * per_cu;
    }
    if (grid_blocks < 0) return;
    if (hipMemsetAsync((unsigned char*)d_ws + WS_BAR, 0, XCD_BAR_WORDS * 4, stream) != hipSuccess) fprintf(stderr, "kernel_launch: hipMemsetAsync failed\n");
    Params p{};
    for (int i = 0; i < 19; ++i) p.in[i] = d_in[i];
    p.out = (float*)d_out; p.ws = (unsigned char*)d_ws;
    void* args[] = {&p};
    const hipError_t e = hipLaunchCooperativeKernel((const void*)fwd_kernel, dim3(grid_blocks), dim3(NWAVES * 64), args, LDS_BYTES, stream);
    if (e != hipSuccess) fprintf(stderr, "kernel_launch: cooperative launch failed: %s (grid %d)\n", hipGetErrorString(e), grid_blocks);
}
```

```cpp
#include <hip/hip_runtime.h>
#include <hip/hip_cooperative_groups.h>
#include <cstdio>
#include <cstdint>
namespace cg = cooperative_groups;
namespace pg8 {
#define PG8_LAS __attribute__((address_space(3)))
typedef unsigned short bf16_t;
typedef short bf16x8 __attribute__((ext_vector_type(8)));
typedef float f32x4 __attribute__((ext_vector_type(4)));
typedef unsigned u32x4 __attribute__((ext_vector_type(4)));
constexpr int BM = 256, BK = 64, HALF = 128, HTB = HALF * BK * 2  , STAGE_BYTES = 8 * HTB, NXCD = 8, WGM = 4;

__host__ __device__ __forceinline__ int lds_byte(int r, int c) { const int st = (r >> 4) * 2 + (c >> 5), rr = r & 15, cc = c & 31, ob = rr * 64 + cc * 2; return st * 1024 + (ob ^ (((ob >> 9) & 1) << 5)); }
__host__ __device__ __forceinline__ void stage_rc(int b, int& R, int& C) { const int st = b / 1024, sb = b % 1024, swz = sb ^ (((sb >> 9) & 1) << 5); R = (st >> 1) * 16 + swz / 64; C = (st & 1) * 32 + (swz % 64) / 2; }
__host__ __device__ __forceinline__ int perm32(int rho) { const int n = rho >> 4, i = rho & 15; return 8 * (i >> 2) + 4 * n + (i & 3); }

struct Unit { int pm, pn; };
struct Gemm { const bf16_t* A; const bf16_t* Bt; int M, N, K; };

struct StaticOrder {
    int nM, nN, nwg, G, c, wgm;
    __host__ __device__ void init(int M, int N, int G_, int c_, int wgm_ = WGM) { nM = M / BM; nN = N / BM; nwg = nM * nN; G = G_; c = c_; wgm = wgm_; }
    __host__ __device__ bool next(int i, Unit& u) const {
        const long L = (long)i * G + c; if (L >= nwg) return false;
        int wgid = (int)L; { const int q = nwg / NXCD, r = nwg % NXCD, xcd = wgid % NXCD, off = wgid / NXCD; wgid = (xcd < r ? xcd * (q + 1) : r * (q + 1) + (xcd - r) * q) + off; }
        const int nig = wgm * nN, gid = wgid / nig, fm = gid * wgm, gsz = (nM - fm) < wgm ? (nM - fm) : wgm;
        u.pm = fm + ((wgid % nig) % gsz); u.pn = (wgid % nig) / gsz; return true;
    }
    __device__ __forceinline__ void a_ready(const Unit&) const {}
    __device__ __forceinline__ void done(const Unit&) const {}
};
__device__ __forceinline__ unsigned cvt_pk_bf16(float lo, float hi) { unsigned r; asm volatile("v_cvt_pk_bf16_f32 %0, %1, %2" : "=v"(r) : "v"(lo), "v"(hi)); return r; }
typedef float f32x2 __attribute__((ext_vector_type(2)));
struct EpiStoreBf16 {
    static constexpr bool PERM = true, AFTER_DRAIN = false;
    bf16_t* O; int ldc;
    __device__ __forceinline__ void operator()(const f32x4 (&acc)[2][2][4][2], const Unit& u, int wr, int wc, int fr, int fq) const {
        const int row0 = u.pm * BM + wr * 64 + fr, col0 = u.pn * BM + wc * 32 + 8 * fq;
#pragma unroll
        for (int ai = 0; ai < 2; ++ai)
#pragma unroll
            for (int m = 0; m < 4; ++m) { bf16_t* rowp = O + (size_t)(row0 + ai * HALF + m * 16) * ldc + col0;
#pragma unroll
                for (int bj = 0; bj < 2; ++bj) { const f32x4 v0 = acc[ai][bj][m][0], v1 = acc[ai][bj][m][1];
                    u32x4 w; w.x = cvt_pk_bf16(v0[0], v0[1]); w.y = cvt_pk_bf16(v0[2], v0[3]); w.z = cvt_pk_bf16(v1[0], v1[1]); w.w = cvt_pk_bf16(v1[2], v1[3]);
                    *(u32x4*)(rowp + bj * HALF) = w; } }
    }
};
struct EpiResF32 {
    static constexpr bool PERM = true, AFTER_DRAIN = false;
    const float* base; float* out; int ldc;
    __device__ __forceinline__ void operator()(const f32x4 (&acc)[2][2][4][2], const Unit& u, int wr, int wc, int fr, int fq) const {
        const int row0 = u.pm * BM + wr * 64 + fr, col0 = u.pn * BM + wc * 32 + 8 * fq;
#pragma unroll
        for (int ai = 0; ai < 2; ++ai)
#pragma unroll
            for (int m = 0; m < 4; ++m) { const size_t off = (size_t)(row0 + ai * HALF + m * 16) * ldc + col0;
#pragma unroll
                for (int bj = 0; bj < 2; ++bj)
#pragma unroll
                    for (int n = 0; n < 2; ++n) { const f32x4 b = *(const f32x4*)(base + off + bj * HALF + 4 * n);
                        *(f32x4*)(out + off + bj * HALF + 4 * n) = b + acc[ai][bj][m][n]; } }
    }
};
struct EpiSwiGLU {
    static constexpr bool PERM = true, AFTER_DRAIN = false;
    bf16_t* O; int ldc; const float* ss;
    static __device__ __forceinline__ float sw(float g, float up) { return g * __builtin_amdgcn_rcpf(1.f + __expf(-g)) * up; }
    __device__ __forceinline__ void operator()(const f32x4 (&acc)[2][2][4][2], const Unit& u, int wr, int wc, int fr, int fq) const {
        const int row0 = u.pm * BM + wr * 64 + fr, col0 = u.pn * HALF + wc * 32 + 8 * fq;
#pragma unroll
        for (int ai = 0; ai < 2; ++ai)
#pragma unroll
            for (int m = 0; m < 4; ++m) { bf16_t* rowp = O + (size_t)(row0 + ai * HALF + m * 16) * ldc + col0;
                const float rstd = rsqrtf(ss[row0 + ai * HALF + m * 16] * (1.f / 2048) + 1e-6f);
                const f32x4 g0 = acc[ai][0][m][0] * rstd, g1 = acc[ai][0][m][1] * rstd, u0 = acc[ai][1][m][0] * rstd, u1 = acc[ai][1][m][1] * rstd;
                u32x4 w; w.x = cvt_pk_bf16(sw(g0[0], u0[0]), sw(g0[1], u0[1])); w.y = cvt_pk_bf16(sw(g0[2], u0[2]), sw(g0[3], u0[3]));
                w.z = cvt_pk_bf16(sw(g1[0], u1[0]), sw(g1[1], u1[1])); w.w = cvt_pk_bf16(sw(g1[2], u1[2]), sw(g1[3], u1[3]));
                *(u32x4*)rowp = w; }
    }
};

struct EpiQKRope {
    static constexpr bool PERM = true, AFTER_DRAIN = false;
    bf16_t* O; int ldc; const unsigned* tab; const float* qgain; const float* kgain; float qscale; unsigned exb;
    __device__ __forceinline__ void operator()(const f32x4 (&acc)[2][2][4][2], const Unit& u, int wr, int wc, int fr_in, int fq_in) const {
        int fr = fr_in, fq = fq_in; asm volatile("" : "+v"(fr), "+v"(fq));
        const int row0 = u.pm * BM + wr * 64 + fr;
        if (u.pn >= 16) {
            const int col0 = u.pn * BM + wc * 32 + 8 * fq;
#pragma unroll
            for (int ai = 0; ai < 2; ++ai)
#pragma unroll
                for (int m = 0; m < 4; ++m) { bf16_t* rowp = O + (size_t)(row0 + ai * HALF + m * 16) * ldc + col0;
#pragma unroll
                    for (int bj = 0; bj < 2; ++bj) { const f32x4 v0 = acc[ai][bj][m][0], v1 = acc[ai][bj][m][1];
                        u32x4 w; w.x = cvt_pk_bf16(v0[0], v0[1]); w.y = cvt_pk_bf16(v0[2], v0[3]); w.z = cvt_pk_bf16(v1[0], v1[1]); w.w = cvt_pk_bf16(v1[2], v1[3]);
                        *(u32x4*)(rowp + bj * HALF) = w; } }
            return;
        }
        const int d0 = 16 * wc + 4 * fq;
        const unsigned xa = exb + 4096u * wr + 16u * fr;
        const unsigned wa = xa + 4u * wc;
#pragma unroll
        for (int ai = 0; ai < 2; ++ai)
#pragma unroll
            for (int m = 0; m < 4; ++m)
#pragma unroll
                for (int bj = 0; bj < 2; ++bj) { const f32x4 v0 = acc[ai][bj][m][0], v1 = acc[ai][bj][m][1];
                    float s = (v0[0] * v0[0] + v0[1] * v0[1]) + (v0[2] * v0[2] + v0[3] * v0[3]) + (v1[0] * v1[0] + v1[1] * v1[1]) + (v1[2] * v1[2] + v1[3] * v1[3]);
                    { float a_ = s, b_ = s; asm volatile("s_nop 1\n\tv_permlane16_swap_b32 %0, %1" : "+v"(a_), "+v"(b_)); a_ += b_; b_ = a_; asm volatile("s_nop 1\n\tv_permlane32_swap_b32 %0, %1" : "+v"(a_), "+v"(b_)); s = a_ + b_; }
                    if (fq == 0) asm volatile("ds_write_b32 %0, %1 offset:%2" :: "v"(wa), "v"(s), "n"(2048 * ai + 512 * m + 256 * bj) : "memory"); }
        u32x4 cs[2][4];
#pragma unroll
        for (int m = 0; m < 4; ++m) cs[0][m] = *(const u32x4*)(tab + (size_t)(row0 + m * 16) * 64 + d0);
        asm volatile("s_waitcnt lgkmcnt(0)" ::: "memory");
        __builtin_amdgcn_s_barrier();
        float rs[2][4][2];
#pragma unroll
        for (int ai = 0; ai < 2; ++ai)
#pragma unroll
            for (int m = 0; m < 4; ++m) { f32x4 p0, p1;
                asm volatile("ds_read_b128 %0, %2 offset:%3\n\tds_read_b128 %1, %2 offset:%4\n\ts_waitcnt lgkmcnt(0)" : "=&v"(p0), "=&v"(p1) : "v"(xa), "n"(2048 * ai + 512 * m), "n"(2048 * ai + 512 * m + 256) : "memory");
                rs[ai][m][0] = rsqrtf(((p0[0] + p0[1]) + (p0[2] + p0[3])) * (1.f / 128) + 1e-6f); rs[ai][m][1] = rsqrtf(((p1[0] + p1[1]) + (p1[2] + p1[3])) * (1.f / 128) + 1e-6f); }
#pragma unroll
        for (int m = 0; m < 4; ++m) cs[1][m] = *(const u32x4*)(tab + (size_t)(row0 + HALF + m * 16) * 64 + d0);
        const bool isq = u.pn < 8; const float* gain = isq ? qgain : kgain; const float sc = isq ? qscale : 1.f;
        const f32x4 g1 = *(const f32x4*)(gain + d0), g2 = *(const f32x4*)(gain + d0 + 64);
#pragma unroll
        for (int ai = 0; ai < 2; ++ai)
#pragma unroll
            for (int m = 0; m < 4; ++m) { const size_t tok = (size_t)(row0 + ai * HALF + m * 16);
                const u32x4 cw = cs[ai][m];
                f32x4 c4, s4;
                c4.x = (float)((int)(cw.x << 16) >> 16); c4.y = (float)((int)(cw.y << 16) >> 16); c4.z = (float)((int)(cw.z << 16) >> 16); c4.w = (float)((int)(cw.w << 16) >> 16);
                s4.x = (float)((int)cw.x >> 16); s4.y = (float)((int)cw.y >> 16); s4.z = (float)((int)cw.z >> 16); s4.w = (float)((int)cw.w >> 16);
                c4 = c4 * (1.f / 32767.f); s4 = s4 * (1.f / 32767.f);
                bf16_t* rowp = O + tok * ldc + u.pn * BM + d0;
#pragma unroll
                for (int bj = 0; bj < 2; ++bj) { const float r = rs[ai][m][bj];
                    const f32x4 y1 = acc[ai][bj][m][0] * r * g1, y2 = acc[ai][bj][m][1] * r * g2;
                    const f32x4 o1 = (y1 * c4 - y2 * s4) * sc, o2 = (y2 * c4 + y1 * s4) * sc;
                    typedef unsigned u32x2 __attribute__((ext_vector_type(2)));
                    u32x2 w1, w2; w1.x = cvt_pk_bf16(o1[0], o1[1]); w1.y = cvt_pk_bf16(o1[2], o1[3]); w2.x = cvt_pk_bf16(o2[0], o2[1]); w2.y = cvt_pk_bf16(o2[2], o2[3]);
                    *(u32x2*)(rowp + bj * HALF) = w1; *(u32x2*)(rowp + bj * HALF + 64) = w2; } }
    }
};

struct EpiKVNorm {
    static constexpr bool PERM = true, AFTER_DRAIN = false;
    bf16_t* O; int ldc; const float* kgain; unsigned exb;
    __device__ __forceinline__ void operator()(const f32x4 (&acc)[2][2][4][2], const Unit& u, int wr, int wc, int fr_in, int fq_in) const {
        int fr = fr_in, fq = fq_in; asm volatile("" : "+v"(fr), "+v"(fq));
        const int row0 = u.pm * BM + wr * 64 + fr, col0 = u.pn * BM + wc * 32 + 8 * fq;
        const unsigned xa = exb + 2048u * wr + 16u * fr, wa = xa + 4u * wc;
#pragma unroll
        for (int ai = 0; ai < 2; ++ai)
#pragma unroll
            for (int m = 0; m < 4; ++m) { const f32x4 v0 = acc[ai][0][m][0], v1 = acc[ai][0][m][1];
                float s = (v0[0] * v0[0] + v0[1] * v0[1]) + (v0[2] * v0[2] + v0[3] * v0[3]) + (v1[0] * v1[0] + v1[1] * v1[1]) + (v1[2] * v1[2] + v1[3] * v1[3]);
                { float a_ = s, b_ = s; asm volatile("s_nop 1\n\tv_permlane16_swap_b32 %0, %1" : "+v"(a_), "+v"(b_)); a_ += b_; b_ = a_; asm volatile("s_nop 1\n\tv_permlane32_swap_b32 %0, %1" : "+v"(a_), "+v"(b_)); s = a_ + b_; }
                if (fq == 0) asm volatile("ds_write_b32 %0, %1 offset:%2" :: "v"(wa), "v"(s), "n"(1024 * ai + 256 * m) : "memory"); }
#pragma unroll
        for (int ai = 0; ai < 2; ++ai)
#pragma unroll
            for (int m = 0; m < 4; ++m) { const f32x4 v0 = acc[ai][1][m][0], v1 = acc[ai][1][m][1];
                u32x4 w; w.x = cvt_pk_bf16(v0[0], v0[1]); w.y = cvt_pk_bf16(v0[2], v0[3]); w.z = cvt_pk_bf16(v1[0], v1[1]); w.w = cvt_pk_bf16(v1[2], v1[3]);
                *(u32x4*)(O + (size_t)(row0 + ai * HALF + m * 16) * ldc + col0 + HALF) = w; }
        asm volatile("s_waitcnt lgkmcnt(0)" ::: "memory");
        __builtin_amdgcn_s_barrier();
        const f32x4 g0 = *(const f32x4*)(kgain + wc * 32 + 8 * fq), g1 = *(const f32x4*)(kgain + wc * 32 + 8 * fq + 4);
#pragma unroll
        for (int ai = 0; ai < 2; ++ai)
#pragma unroll
            for (int mp = 0; mp < 2; ++mp) { f32x4 p0, p1;
                asm volatile("ds_read_b128 %0, %2 offset:%3\n\tds_read_b128 %1, %2 offset:%4\n\ts_waitcnt lgkmcnt(0)" : "=&v"(p0), "=&v"(p1) : "v"(xa), "n"(1024 * ai + 512 * mp), "n"(1024 * ai + 512 * mp + 256) : "memory");
                const float r0 = rsqrtf(((p0[0] + p0[1]) + (p0[2] + p0[3])) * (1.f / 128) + 1e-6f), r1 = rsqrtf(((p1[0] + p1[1]) + (p1[2] + p1[3])) * (1.f / 128) + 1e-6f);
                { const int m = 2 * mp; const f32x4 v0 = acc[ai][0][m][0] * r0 * g0, v1 = acc[ai][0][m][1] * r0 * g1;
                  u32x4 w; w.x = cvt_pk_bf16(v0[0], v0[1]); w.y = cvt_pk_bf16(v0[2], v0[3]); w.z = cvt_pk_bf16(v1[0], v1[1]); w.w = cvt_pk_bf16(v1[2], v1[3]);
                  *(u32x4*)(O + (size_t)(row0 + ai * HALF + m * 16) * ldc + col0) = w; }
                { const int m = 2 * mp + 1; const f32x4 v0 = acc[ai][0][m][0] * r1 * g0, v1 = acc[ai][0][m][1] * r1 * g1;
                  u32x4 w; w.x = cvt_pk_bf16(v0[0], v0[1]); w.y = cvt_pk_bf16(v0[2], v0[3]); w.z = cvt_pk_bf16(v1[0], v1[1]); w.w = cvt_pk_bf16(v1[2], v1[3]);
                  *(u32x4*)(O + (size_t)(row0 + ai * HALF + m * 16) * ldc + col0) = w; } }
    }
};

struct EpiResF32Stat {
    static constexpr bool PERM = true, AFTER_DRAIN = false;
    const float* base; float* out; int ldc; bf16_t* xb; float* ss;
    __device__ __forceinline__ void operator()(const f32x4 (&acc)[2][2][4][2], const Unit& u, int wr, int wc, int fr, int fq) const {
        const int row0 = u.pm * BM + wr * 64 + fr, col0 = u.pn * BM + wc * 32 + 8 * fq;
#pragma unroll
        for (int ai = 0; ai < 2; ++ai)
#pragma unroll
            for (int m = 0; m < 4; ++m) { const int row = row0 + ai * HALF + m * 16; const size_t off = (size_t)row * ldc + col0; float s = 0.f;
#pragma unroll
                for (int bj = 0; bj < 2; ++bj) { const f32x4 v0 = *(const f32x4*)(base + off + bj * HALF) + acc[ai][bj][m][0], v1 = *(const f32x4*)(base + off + bj * HALF + 4) + acc[ai][bj][m][1];
                    *(f32x4*)(out + off + bj * HALF) = v0; *(f32x4*)(out + off + bj * HALF + 4) = v1;
                    u32x4 w; w.x = cvt_pk_bf16(v0[0], v0[1]); w.y = cvt_pk_bf16(v0[2], v0[3]); w.z = cvt_pk_bf16(v1[0], v1[1]); w.w = cvt_pk_bf16(v1[2], v1[3]);
                    *(u32x4*)(xb + off + bj * HALF) = w;
                    s += (v0[0] * v0[0] + v0[1] * v0[1]) + (v0[2] * v0[2] + v0[3] * v0[3]) + (v1[0] * v1[0] + v1[1] * v1[1]) + (v1[2] * v1[2] + v1[3] * v1[3]); }
                { float a_ = s, b_ = s; asm volatile("s_nop 1\n\tv_permlane16_swap_b32 %0, %1" : "+v"(a_), "+v"(b_)); a_ += b_; b_ = a_; asm volatile("s_nop 1\n\tv_permlane32_swap_b32 %0, %1" : "+v"(a_), "+v"(b_)); s = a_ + b_; }
                if (fq == 0) __hip_atomic_fetch_add(ss + row, s, __ATOMIC_RELAXED, __HIP_MEMORY_SCOPE_AGENT); }
    }
};
template <class Epi, class Sched, bool ALIGN_EPI = false, bool SP2 = false>
__device__ __forceinline__ void gemm_phase(PG8_LAS unsigned char* lds, const Gemm g, const Sched& S, const Epi& E) {
    int tid_ = threadIdx.x; asm volatile("" : "+v"(tid_));
    const int tid = tid_, wid = __builtin_amdgcn_readfirstlane(tid >> 6), lane = tid & 63, wr = wid >> 2, wc = wid & 3, fr = lane & 15, fq = lane >> 4;
    const int K = g.K, nt = K / BK;
    unsigned voffA[2], voffB[2];
#pragma unroll
    for (int i = 0; i < 2; ++i) { int R, C; stage_rc(tid * 16 + i * 8192, R, C); const int Rb = Epi::PERM ? ((R & ~31) + perm32(R & 31)) : R;
        voffA[i] = (unsigned)(R * K + C) * 2u; voffB[i] = (unsigned)(Rb * K + C) * 2u; }
    const size_t kstep = (size_t)(BK * 2);
    const size_t hstep = (size_t)HALF * K * 2;
    const size_t tstep = 2 * hstep;
    const unsigned ldsw = (unsigned)wid * 1024u;
    const int aoff = lds_byte(wr * 64 + fr, fq * 8), boff = lds_byte(wc * 32 + fr, fq * 8);
#define PG8_SA(b, h) (((b) * 2 + (h)) * HTB)
#define PG8_SB(b, h) ((4 + (b) * 2 + (h)) * HTB)
#define PG8_STAGE(bufoff, gbase, voff) do { _Pragma("unroll") for (int _i = 0; _i < 2; ++_i) \
        __builtin_amdgcn_global_load_lds((const unsigned*)((const char*)(gbase) + (voff)[_i]), (PG8_LAS unsigned*)(lds + (bufoff) + ldsw + _i * 8192), 16, 0, 0); } while (0)
#define PG8_LDA(dst, b, h) do { _Pragma("unroll") for (int m = 0; m < 4; ++m) _Pragma("unroll") for (int k = 0; k < 2; ++k) dst[m][k] = *(const PG8_LAS bf16x8*)(lds + PG8_SA(b, h) + aoff + m * 2048 + k * 1024); } while (0)
#define PG8_LDB(dst, b, h) do { _Pragma("unroll") for (int n = 0; n < 2; ++n) _Pragma("unroll") for (int k = 0; k < 2; ++k) dst[n][k] = *(const PG8_LAS bf16x8*)(lds + PG8_SB(b, h) + boff + n * 2048 + k * 1024); } while (0)
#define PG8_MMA(ai, bj, At, Bt) do { __builtin_amdgcn_s_setprio(1); _Pragma("unroll") for (int m = 0; m < 4; ++m) _Pragma("unroll") for (int n = 0; n < 2; ++n) _Pragma("unroll") for (int k = 0; k < 2; ++k) \
        acc[ai][bj][m][n] = __builtin_amdgcn_mfma_f32_16x16x32_bf16(Bt[n][k], At[m][k], acc[ai][bj][m][n], 0, 0, 0); __builtin_amdgcn_s_setprio(0); } while (0)
#define PG8_WAIT_V(n) asm volatile("s_waitcnt vmcnt(" #n ")" ::: "memory")
#define PG8_WAIT_L(n) asm volatile("s_waitcnt lgkmcnt(" #n ")" ::: "memory")
#define PG8_BAR __builtin_amdgcn_s_barrier()
#define PG8_SCHED __builtin_amdgcn_sched_barrier(0)
    Unit cur, nxt; int ui = 0;
    if (!S.next(0, cur)) return;
    f32x4 acc[2][2][4][2];
#pragma unroll
    for (int a = 0; a < 2; ++a)
#pragma unroll
        for (int b = 0; b < 2; ++b)
#pragma unroll
            for (int m = 0; m < 4; ++m)
#pragma unroll
                for (int n = 0; n < 2; ++n) acc[a][b][m][n] = (f32x4){0.f, 0.f, 0.f, 0.f};
    bf16x8 At[4][2], B0[2][2], B1[2][2];
    const char* cA = (const char*)g.A + (size_t)cur.pm * tstep; const char* cB = (const char*)g.Bt + (size_t)cur.pn * tstep;
    S.a_ready(cur);
    if constexpr (SP2) {
        PG8_STAGE(PG8_SB(0, 0), cB, voffB); PG8_STAGE(PG8_SB(0, 1), cB + hstep, voffB); PG8_STAGE(PG8_SA(0, 0), cA, voffA); PG8_STAGE(PG8_SA(0, 1), cA + hstep, voffA);
        if (wr == 1) PG8_BAR;
        PG8_WAIT_V(2); PG8_BAR;
        PG8_STAGE(PG8_SB(1, 0), cB + kstep, voffB); PG8_STAGE(PG8_SA(1, 0), cA + kstep, voffA); PG8_STAGE(PG8_SB(1, 1), cB + hstep + kstep, voffB);
        PG8_WAIT_V(6); PG8_BAR;
    } else {
        PG8_STAGE(PG8_SB(0, 0), cB, voffB); PG8_STAGE(PG8_SA(0, 0), cA, voffA); PG8_STAGE(PG8_SB(0, 1), cB + hstep, voffB); PG8_STAGE(PG8_SA(0, 1), cA + hstep, voffA);
        if (wr == 1) PG8_BAR;
        PG8_WAIT_V(4); PG8_BAR;
        PG8_STAGE(PG8_SB(1, 0), cB + kstep, voffB); PG8_STAGE(PG8_SA(1, 0), cA + kstep, voffA); PG8_STAGE(PG8_SB(1, 1), cB + hstep + kstep, voffB);
        PG8_WAIT_V(6); PG8_BAR;
    }
    for (;;) {
        const bool has_next = S.next(ui + 1, nxt);
        const char* nA = has_next ? (const char*)g.A + (size_t)nxt.pm * tstep : cA; const char* nB = has_next ? (const char*)g.Bt + (size_t)nxt.pn * tstep : cB;
        for (int t = 0; t < nt; t += 2) {
            const bool last = (t == nt - 2);
            const char* a1 = cA + (size_t)(t + 1) * kstep;
            const char* a2 = last ? nA : cA + (size_t)(t + 2) * kstep; const char* b2 = last ? nB : cB + (size_t)(t + 2) * kstep;
            const char* a3 = a2 + kstep; const char* b3 = b2 + kstep;
            if (last && has_next) S.a_ready(nxt);
            if constexpr (SP2) {
            PG8_LDB(B0, 0, 0); PG8_LDB(B1, 0, 1); PG8_SCHED; PG8_LDA(At, 0, 0); PG8_STAGE(PG8_SA(1, 1), a1 + hstep, voffA);
            PG8_WAIT_V(8); PG8_WAIT_L(0); PG8_BAR; PG8_MMA(0, 0, At, B0); PG8_MMA(0, 1, At, B1); PG8_BAR; PG8_SCHED;
            PG8_LDA(At, 0, 1); PG8_STAGE(PG8_SB(0, 0), b2, voffB); PG8_STAGE(PG8_SB(0, 1), b2 + hstep, voffB); PG8_STAGE(PG8_SA(0, 0), a2, voffA);
            PG8_WAIT_V(8); PG8_WAIT_L(0); PG8_BAR; PG8_MMA(1, 0, At, B0); PG8_MMA(1, 1, At, B1); PG8_BAR; PG8_SCHED;
            PG8_LDB(B0, 1, 0); PG8_LDB(B1, 1, 1); PG8_SCHED; PG8_LDA(At, 1, 0); PG8_STAGE(PG8_SA(0, 1), a2 + hstep, voffA);
            PG8_WAIT_V(8); PG8_WAIT_L(0); PG8_BAR; PG8_MMA(0, 0, At, B0); PG8_MMA(0, 1, At, B1); PG8_BAR; PG8_SCHED;
            PG8_LDA(At, 1, 1); PG8_STAGE(PG8_SB(1, 0), b3, voffB); PG8_STAGE(PG8_SB(1, 1), b3 + hstep, voffB); PG8_STAGE(PG8_SA(1, 0), a3, voffA);
            PG8_WAIT_V(8); PG8_WAIT_L(0); PG8_BAR; PG8_MMA(1, 0, At, B0); PG8_MMA(1, 1, At, B1); PG8_BAR; PG8_SCHED;
            } else {
            PG8_LDB(B0, 0, 0); PG8_SCHED; PG8_LDA(At, 0, 0); PG8_STAGE(PG8_SA(1, 1), a1 + hstep, voffA);
            PG8_WAIT_L(8); PG8_BAR; PG8_WAIT_L(0); PG8_MMA(0, 0, At, B0); PG8_BAR; PG8_SCHED;
            PG8_LDB(B1, 0, 1); PG8_STAGE(PG8_SB(0, 0), b2, voffB);
            PG8_BAR; PG8_WAIT_L(0); PG8_MMA(0, 1, At, B1); PG8_BAR;
            PG8_LDA(At, 0, 1); PG8_STAGE(PG8_SA(0, 0), a2, voffA);
            PG8_BAR; PG8_WAIT_L(0); PG8_MMA(1, 0, At, B0); PG8_BAR; PG8_SCHED;
            PG8_STAGE(PG8_SB(0, 1), b2 + hstep, voffB);
            PG8_WAIT_V(6); PG8_BAR; PG8_MMA(1, 1, At, B1); PG8_BAR;
            PG8_LDB(B0, 1, 0); PG8_SCHED; PG8_LDA(At, 1, 0); PG8_STAGE(PG8_SA(0, 1), a2 + hstep, voffA);
            PG8_WAIT_L(8); PG8_BAR; PG8_WAIT_L(0); PG8_MMA(0, 0, At, B0); PG8_BAR; PG8_SCHED;
            PG8_LDB(B1, 1, 1); PG8_STAGE(PG8_SB(1, 0), b3, voffB);
            PG8_BAR; PG8_WAIT_L(0); PG8_MMA(0, 1, At, B1); PG8_BAR;
            PG8_LDA(At, 1, 1); PG8_STAGE(PG8_SA(1, 0), a3, voffA);
            PG8_BAR; PG8_WAIT_L(0); PG8_MMA(1, 0, At, B0); PG8_BAR; PG8_SCHED;
            PG8_STAGE(PG8_SB(1, 1), b3 + hstep, voffB);
            PG8_WAIT_V(6); PG8_BAR; PG8_MMA(1, 1, At, B1); PG8_BAR;
            }
        }
        if constexpr (ALIGN_EPI) { if (wr == 0) PG8_BAR; }
        if constexpr (!Epi::AFTER_DRAIN) { E(acc, cur, wr, wc, fr, fq); S.done(cur); }
        if (!has_next) break;
#pragma unroll
        for (int a = 0; a < 2; ++a)
#pragma unroll
            for (int b = 0; b < 2; ++b)
#pragma unroll
                for (int m = 0; m < 4; ++m)
#pragma unroll
                    for (int n = 0; n < 2; ++n) acc[a][b][m][n] = (f32x4){0.f, 0.f, 0.f, 0.f};
        cur = nxt; cA = nA; cB = nB; ++ui;
        if constexpr (ALIGN_EPI) { if (wr == 1) PG8_BAR; }
    }
    PG8_WAIT_V(0);
    if constexpr (!ALIGN_EPI) { if (wr == 0) PG8_BAR; }
    PG8_BAR;
    if constexpr (Epi::AFTER_DRAIN) { E.fused(acc, cur, wr, wc, fr, fq, lds, wid, lane); S.done(cur); }
#undef PG8_SA
#undef PG8_SB
#undef PG8_STAGE
#undef PG8_LDA
#undef PG8_LDB
#undef PG8_MMA
#undef PG8_WAIT_V
#undef PG8_WAIT_L
#undef PG8_BAR
#undef PG8_SCHED
}
}
#define LAS __attribute__((address_space(3)))
typedef unsigned short bf16;
typedef unsigned v4u __attribute__((ext_vector_type(4)));
typedef unsigned v2u __attribute__((ext_vector_type(2)));
typedef float f32x4 __attribute__((ext_vector_type(4)));
typedef short s16x8 __attribute__((ext_vector_type(8)));
typedef short s16x4 __attribute__((ext_vector_type(4)));

constexpr int NB = 8, SEQ = 2048, DM = 2048, NTOK = NB * SEQ, FF = 5632, NWAVES = 8;
constexpr int DOWN_N = 1088, DOWN_NP = 1280;
constexpr float EPS = 1e-6f;
constexpr float LOG2E = 1.4426950408889634f, LN2 = 0.6931471805599453f;
constexpr float QSCALE_MLA = 0.07216878364870322f * LOG2E;
constexpr float QSCALE_DIL = 0.08838834764831845f * LOG2E;
constexpr int LDS_BYTES = 147456;

constexpr size_t MiB = (size_t)1 << 20;
constexpr size_t WS_WQKV = 0, WS_WD = 0, WS_WUQ = 8 * MiB, WS_WUKV = 12 * MiB, WS_WO = 72 * MiB, WS_WGU = 80 * MiB, WS_WDN = 124 * MiB;
constexpr size_t WS_BAR = 146 * MiB;
constexpr int MISC_OFF = 131072 + 320, EX_OFF = 131072 + 1024;
constexpr size_t WS_SS = 279 * MiB;
constexpr size_t WS_MTAB = 277 * MiB;
constexpr size_t WS_H = 148 * MiB, WS_O = 212 * MiB, WS_LSE = 276 * MiB;
constexpr size_t WS_DOWN = 280 * MiB, WS_CQ = 320 * MiB, WS_CKV = 336 * MiB, WS_KROPE = 352 * MiB, WS_QRAW = 356 * MiB, WS_KVRAW = 452 * MiB;
constexpr size_t WS_COST = 280 * MiB, WS_SINT = 284 * MiB;
constexpr size_t WS_A = 356 * MiB, WS_QKVG = 356 * MiB, WS_END = 580 * MiB;

struct Params { const void* in[19]; float* out; unsigned char* ws; };

__device__ __forceinline__ unsigned f2bf(float f) { unsigned u = __builtin_bit_cast(unsigned, f); return (u + 0x7fffu + ((u >> 16) & 1u)) >> 16; }
__device__ __forceinline__ unsigned pk2(float lo, float hi) { unsigned r; asm("v_cvt_pk_bf16_f32 %0, %1, %2" : "=v"(r) : "v"(lo), "v"(hi)); return r; }
__device__ __forceinline__ float bf2f(unsigned u) { return __builtin_bit_cast(float, u << 16); }
__device__ __forceinline__ float shfl_xor_l(float v, int o) { int l = (int)__builtin_amdgcn_mbcnt_hi(~0u, __builtin_amdgcn_mbcnt_lo(~0u, 0u)); asm volatile("" : "+v"(l));
    return __builtin_bit_cast(float, __builtin_amdgcn_ds_bpermute((l ^ o) << 2, __builtin_bit_cast(int, v))); }
__device__ __forceinline__ float wave_sum(float v) {
#pragma unroll
    for (int o = 1; o < 64; o <<= 1) v += shfl_xor_l(v, o);
    return v;
}
#define LDS_WAIT() asm volatile("s_waitcnt lgkmcnt(0)" ::: "memory")
__device__ __forceinline__ void swap16(float& a, float& b) { asm volatile("s_nop 1\n\tv_permlane16_swap_b32 %0, %1" : "+v"(a), "+v"(b)); }
__device__ __forceinline__ void swap32(float& a, float& b) { asm volatile("s_nop 1\n\tv_permlane32_swap_b32 %0, %1" : "+v"(a), "+v"(b)); }
__device__ __forceinline__ float xmax4(float x) { float a = x, b = x; swap16(a, b); a = fmaxf(a, b); b = a; swap32(a, b); return fmaxf(a, b); }
__device__ __forceinline__ float xsum4(float x) { float a = x, b = x; swap16(a, b); a = a + b; b = a; swap32(a, b); return a + b; }

template <bool QKPERM, bool GAIN> __device__ __forceinline__ void tr_item(const float* W, int K, int N, bf16* WT, int k0, int n0, int dst_row0, LAS float* scr, int lane, int dbase, const float* kgain) {
    float wv[32];
#pragma unroll
    for (int i = 0; i < 32; ++i) { const int kk = 2 * i + (lane >> 5); wv[i] = W[(size_t)(k0 + kk) * N + n0 + (lane & 31)]; }
#pragma unroll
    for (int i = 0; i < 32; ++i) { const int kk = 2 * i + (lane >> 5); scr[kk * 33 + (lane & 31)] = GAIN ? wv[i] * kgain[k0 + kk] : wv[i]; }
    LDS_WAIT();
    const int c = lane & 7;
#pragma unroll
    for (int j = 0; j < 4; ++j) { const int n = (lane >> 3) + 8 * j; const LAS float* s = scr + (8 * c) * 33 + n;
        v4u o; o.x = pk2(s[0 * 33], s[1 * 33]); o.y = pk2(s[2 * 33], s[3 * 33]); o.z = pk2(s[4 * 33], s[5 * 33]); o.w = pk2(s[6 * 33], s[7 * 33]);
        int rown = dst_row0 + n; if (QKPERM) { const int d = dbase + n, r = d & 63; rown = dst_row0 + 32 * (r >> 4) + 8 * ((r >> 2) & 3) + 4 * (d >> 6) + (d & 3); }
        *(v4u*)(WT + (size_t)rown * K + k0 + 8 * c) = o; }
    LDS_WAIT();
}
template <int MAP, bool GAIN = false> __device__ __forceinline__ void conv_matrix(const float* W, int K, int N, bf16* WT, int which, LAS float* scr, int gw, int ngw, int lane, const float* kgain = nullptr) {
    const int nblk = N / 32, items = (K / 64) * nblk;
    for (int it = gw; it < items; it += ngw) {
        const int kb = it / nblk, nb = it - kb * nblk, n0 = 32 * nb;
        int dst = n0;
        if (MAP == 1) dst = 256 * (n0 >> 7) + 128 * which + (n0 & 127);
        if (MAP == 2) { const int w = n0 / 6144, rem = n0 - w * 6144, g = rem >> 11, hd = rem & 2047; dst = g * 6144 + w * 2048 + hd;
            if (w < 2) { tr_item<true, GAIN>(W, K, N, WT, 64 * kb, n0, dst - (hd & 127), scr, lane, hd & 127, kgain); continue; } }
        tr_item<false, GAIN>(W, K, N, WT, 64 * kb, n0, dst, scr, lane, 0, kgain);
    }
}
__device__ __forceinline__ void norm_rows(const float* xin, const float* gain, bf16* H, int gw, int ngw, int lane) {
    for (int row = gw; row < NTOK; row += ngw) {
        const f32x4* xr = (const f32x4*)(xin + (size_t)row * DM) + lane;
        const f32x4* gr = (const f32x4*)gain + lane;
        f32x4 v[8]; float s = 0.f;
#pragma unroll
        for (int j = 0; j < 8; ++j) { v[j] = xr[64 * j]; s += (v[j].x * v[j].x + v[j].y * v[j].y) + (v[j].z * v[j].z + v[j].w * v[j].w); }
        const float rstd = rsqrtf(wave_sum(s) * (1.f / DM) + EPS);
        v2u* o8 = (v2u*)(H + (size_t)row * DM) + lane;
#pragma unroll
        for (int j = 0; j < 8; ++j) { const f32x4 g = gr[64 * j]; v2u w; w.x = pk2(v[j].x * rstd * g.x, v[j].y * rstd * g.y); w.y = pk2(v[j].z * rstd * g.z, v[j].w * rstd * g.w); o8[64 * j] = w; }
    }
}

struct AttnArgs {
    const bf16* q; long qp;
    const bf16* k; long kp;
    const bf16* k2; long k2p;
    const bf16* v; long vp;
    bf16* o; long op;
    float* lse; long lsep;
    const unsigned* qtab; const float* qgain;
    int cstart, nt, W, mode;
};
typedef short v4i16_t __attribute__((ext_vector_type(4)));
__device__ __forceinline__ s16x4 vtr(LAS const unsigned char* p) { return __builtin_bit_cast(s16x4, __builtin_amdgcn_ds_read_tr16_b64_v4i16((LAS v4i16_t*)p)); }

template <int DK, int RB, bool QPF, bool QN, class Sched>
__device__ __forceinline__ void attn_phase(LAS unsigned char* lds, const Sched& S, int tid, int wave, int lane) {
    constexpr int KS = DK / 32, KPB = DK * 2 + 16, NKL = (DK == 192) ? 3 : 2, VPB = 288, KOFF = 0, VOFF = 32768;
    const int fr = lane & 15, fq = lane >> 4;
    AttnArgs a, nx;
    bool has = S.get(0, a);
    if (!has) return;
    unsigned koff[NKL], voff[2], kdst[NKL], vdst[2];
#pragma unroll
    for (int p = 0; p < 2; ++p) { const int id = tid + 512 * p, row = id >> 4, ch = id & 15;
        koff[p] = (unsigned)(row * (int)a.kp + ch * 8) * 2u; kdst[p] = KOFF + row * KPB + ch * 16; voff[p] = (unsigned)(row * (int)a.vp + ch * 8) * 2u; vdst[p] = VOFF + row * VPB + ch * 16; }
    if (DK == 192) { const int row = tid >> 3, ch = tid & 7; koff[NKL - 1] = (unsigned)(row * (int)a.k2p + ch * 8) * 2u; kdst[NKL - 1] = KOFF + row * KPB + 256 + ch * 16; }
    const long kstep = 128 * a.kp, k2step = 128 * a.k2p, vstep = 128 * a.vp;
    const char* ktile; const char* k2tile = nullptr; const char* vtile;
    v4u kreg[NKL], vreg[2];
    s16x8 qn[QPF ? RB : 1][KS];
#define ATT_BASE(A) do { ktile = (const char*)((A).k + (long)(A).cstart * (A).kp); if (DK == 192) k2tile = (const char*)((A).k2 + (long)(A).cstart * (A).k2p); vtile = (const char*)((A).v + (long)(A).cstart * (A).vp); } while (0)
#define ATT_LOAD() do { \
        kreg[0] = *(const v4u*)(ktile + koff[0]); kreg[1] = *(const v4u*)(ktile + koff[1]); if (DK == 192) kreg[NKL - 1] = *(const v4u*)(k2tile + koff[NKL - 1]); \
        vreg[0] = *(const v4u*)(vtile + voff[0]); vreg[1] = *(const v4u*)(vtile + voff[1]); ktile += kstep; vtile += vstep; if (DK == 192) k2tile += k2step; } while (0)
#define ATT_QLOAD(DST, A) do { _Pragma("unroll") for (int rb_ = 0; rb_ < RB; ++rb_) { const bf16* qrow_ = (A).q + (long)(wave * 16 * RB + rb_ * 16 + fr) * (A).qp + fq * 8; \
        _Pragma("unroll") for (int ks_ = 0; ks_ < KS; ++ks_) DST[rb_][ks_] = *(const s16x8*)(qrow_ + ks_ * 32); } } while (0)
    if (QPF) ATT_QLOAD(qn, a);
    ATT_BASE(a); ATT_LOAD();
    const int w_lo = wave * 16 * RB, w_hi = w_lo + 16 * RB - 1;
    for (int ui = 0; has; ++ui) {
        const bool hasn = S.get(ui + 1, nx);
        s16x8 qf[RB][KS];
        if (QPF) {
#pragma unroll
            for (int rb = 0; rb < RB; ++rb)
#pragma unroll
                for (int ks = 0; ks < KS; ++ks) qf[rb][ks] = qn[rb][ks];
        } else ATT_QLOAD(qf, a);
        if (QN) {
#pragma unroll
            for (int rb = 0; rb < RB; ++rb) {
                const unsigned* tr = a.qtab + (size_t)(w_lo + rb * 16 + fr) * 32 + fq * 8;
                const v4u t0 = *(const v4u*)tr, t1 = *(const v4u*)(tr + 4);
                float x[KS][8]; float ssn = 0.f, ssr = 0.f;
#pragma unroll
                for (int ks = 0; ks < KS; ++ks)
#pragma unroll
                    for (int e = 0; e < 8; ++e) { x[ks][e] = bf2f((unsigned short)qf[rb][ks][e]); if (ks < 4) ssn += x[ks][e] * x[ks][e]; else ssr += x[ks][e] * x[ks][e]; }
                ssn = xsum4(ssn); ssr = xsum4(ssr);
                const float rn = rsqrtf(ssn * (1.f / 128) + EPS) * QSCALE_MLA, rr = rsqrtf(ssr * (1.f / 64) + EPS);
#pragma unroll
                for (int ks = 0; ks < 4; ++ks) { const f32x4 g0 = *(const f32x4*)(a.qgain + ks * 32 + fq * 8), g1 = *(const f32x4*)(a.qgain + ks * 32 + fq * 8 + 4);
                    v4u w; w.x = pk2(x[ks][0] * rn * g0.x, x[ks][1] * rn * g0.y); w.y = pk2(x[ks][2] * rn * g0.z, x[ks][3] * rn * g0.w); w.z = pk2(x[ks][4] * rn * g1.x, x[ks][5] * rn * g1.y); w.w = pk2(x[ks][6] * rn * g1.z, x[ks][7] * rn * g1.w);
                    qf[rb][ks] = __builtin_bit_cast(s16x8, w); }
                { const f32x4 ga0 = *(const f32x4*)(a.qgain + 128 + fq * 8), ga1 = *(const f32x4*)(a.qgain + 132 + fq * 8), gb0 = *(const f32x4*)(a.qgain + 160 + fq * 8), gb1 = *(const f32x4*)(a.qgain + 164 + fq * 8);
                  const float gA[8] = {ga0.x, ga0.y, ga0.z, ga0.w, ga1.x, ga1.y, ga1.z, ga1.w}, gB[8] = {gb0.x, gb0.y, gb0.z, gb0.w, gb1.x, gb1.y, gb1.z, gb1.w};
                  const unsigned tw[8] = {t0.x, t0.y, t0.z, t0.w, t1.x, t1.y, t1.z, t1.w};
                  float o1[8], o2[8];
#pragma unroll
                  for (int e = 0; e < 8; ++e) { const float cs = (float)((int)(tw[e] << 16) >> 16) * (1.f / 32767.f), sn = (float)((int)tw[e] >> 16) * (1.f / 32767.f);
                      const float y1 = x[4][e] * rr * gA[e], y2 = x[5][e] * rr * gB[e]; o1[e] = (y1 * cs - y2 * sn) * QSCALE_MLA; o2[e] = (y2 * cs + y1 * sn) * QSCALE_MLA; }
                  v4u w1, w2; w1.x = pk2(o1[0], o1[1]); w1.y = pk2(o1[2], o1[3]); w1.z = pk2(o1[4], o1[5]); w1.w = pk2(o1[6], o1[7]); w2.x = pk2(o2[0], o2[1]); w2.y = pk2(o2[2], o2[3]); w2.z = pk2(o2[4], o2[5]); w2.w = pk2(o2[6], o2[7]);
                  qf[rb][4] = __builtin_bit_cast(s16x8, w1); qf[rb][5] = __builtin_bit_cast(s16x8, w2); }
            }
        }
        v2u oldo[RB][8]; float oldl[RB];
        if (a.mode == 2) {
#pragma unroll
            for (int rb = 0; rb < RB; ++rb) { const int iq = w_lo + rb * 16 + fr; const bf16* orow = a.o + (long)iq * a.op + fq * 4; oldl[rb] = a.lse[(long)iq * a.lsep];
#pragma unroll
                for (int db = 0; db < 8; ++db) oldo[rb][db] = *(const v2u*)(orow + db * 16); }
        }
        f32x4 o[RB][8];
        float m[RB], l[RB];
#pragma unroll
        for (int rb = 0; rb < RB; ++rb) { m[rb] = -1e30f; l[rb] = 0.f;
#pragma unroll
            for (int db = 0; db < 8; ++db) o[rb][db] = (f32x4){0.f, 0.f, 0.f, 0.f}; }
        for (int t = 0; t < a.nt; ++t) {
            __syncthreads();
#pragma unroll
            for (int p = 0; p < NKL; ++p) *(LAS v4u*)(lds + kdst[p]) = kreg[p];
#pragma unroll
            for (int p = 0; p < 2; ++p) *(LAS v4u*)(lds + vdst[p]) = vreg[p];
            __syncthreads();
            if (t + 1 < a.nt) ATT_LOAD();
            else if (hasn) { if (QPF) ATT_QLOAD(qn, nx); ATT_BASE(nx); ATT_LOAD(); }
            const int ct = a.cstart + 64 * t;
            const bool needed = (ct <= w_hi) && (ct + 63 >= w_lo - a.W);
            if (needed) {
                f32x4 s[RB][4];
#pragma unroll
                for (int kb = 0; kb < 4; ++kb) {
#pragma unroll
                    for (int rb = 0; rb < RB; ++rb) s[rb][kb] = (f32x4){0.f, 0.f, 0.f, 0.f};
                    const int row = kb * 16 + fr;
                    LAS const unsigned char* kp = lds + KOFF + row * KPB + fq * 16;
#pragma unroll
                    for (int ks = 0; ks < KS; ++ks) { const s16x8 kf = *(LAS const s16x8*)(kp + ks * 64);
#pragma unroll
                        for (int rb = 0; rb < RB; ++rb) s[rb][kb] = __builtin_amdgcn_mfma_f32_16x16x32_bf16(kf, qf[rb][ks], s[rb][kb], 0, 0, 0); }
                }
                s16x8 pf[RB][2];
#pragma unroll
                for (int rb = 0; rb < RB; ++rb) {
                    const int i_lo = w_lo + rb * 16, i_hi = i_lo + 15, iq = i_lo + fr;
                    const bool full = (ct + 63 <= i_lo) && (ct >= i_hi - a.W);
                    if (!full) {
#pragma unroll
                        for (int kb = 0; kb < 4; ++kb)
#pragma unroll
                            for (int j = 0; j < 4; ++j) { const int c = ct + kb * 16 + fq * 4 + j; const bool ok = (c <= iq) && (c >= iq - a.W); s[rb][kb][j] = ok ? s[rb][kb][j] : -1e30f; }
                    }
                    float mx = fmaxf(fmaxf(fmaxf(s[rb][0][0], s[rb][0][1]), fmaxf(s[rb][0][2], s[rb][0][3])), fmaxf(fmaxf(s[rb][1][0], s[rb][1][1]), fmaxf(s[rb][1][2], s[rb][1][3])));
                    mx = fmaxf(mx, fmaxf(fmaxf(fmaxf(s[rb][2][0], s[rb][2][1]), fmaxf(s[rb][2][2], s[rb][2][3])), fmaxf(fmaxf(s[rb][3][0], s[rb][3][1]), fmaxf(s[rb][3][2], s[rb][3][3]))));
                    mx = xmax4(mx);
                    const float mn = fmaxf(m[rb], mx), alpha = __builtin_amdgcn_exp2f(m[rb] - mn);
                    m[rb] = mn;
                    float ps = 0.f;
#pragma unroll
                    for (int kb = 0; kb < 4; ++kb)
#pragma unroll
                        for (int j = 0; j < 4; ++j) { s[rb][kb][j] = __builtin_amdgcn_exp2f(s[rb][kb][j] - mn); ps += s[rb][kb][j]; }
                    l[rb] = l[rb] * alpha + ps;
                    if (__builtin_amdgcn_ballot_w64(alpha != 1.f) != 0ull) {
#pragma unroll
                        for (int db = 0; db < 8; ++db) o[rb][db] = o[rb][db] * alpha; }
#pragma unroll
                    for (int h2 = 0; h2 < 2; ++h2) { v4u w; w.x = pk2(s[rb][2 * h2][0], s[rb][2 * h2][1]); w.y = pk2(s[rb][2 * h2][2], s[rb][2 * h2][3]); w.z = pk2(s[rb][2 * h2 + 1][0], s[rb][2 * h2 + 1][1]); w.w = pk2(s[rb][2 * h2 + 1][2], s[rb][2 * h2 + 1][3]);
                        pf[rb][h2] = __builtin_bit_cast(s16x8, w); }
                }
#pragma unroll
                for (int db = 0; db < 8; ++db)
#pragma unroll
                    for (int h2 = 0; h2 < 2; ++h2) {
                        LAS const unsigned char* vp = lds + VOFF + (h2 * 32 + fq * 4 + (fr >> 2)) * VPB + (db * 16 + (fr & 3) * 4) * 2;
                        const s16x4 lo = vtr(vp), hi = vtr(vp + 16 * VPB);
                        const s16x8 vf = {lo[0], lo[1], lo[2], lo[3], hi[0], hi[1], hi[2], hi[3]};
#pragma unroll
                        for (int rb = 0; rb < RB; ++rb) o[rb][db] = __builtin_amdgcn_mfma_f32_16x16x32_bf16(vf, pf[rb][h2], o[rb][db], 0, 0, 0);
                    }
            }
        }
#pragma unroll
        for (int rb = 0; rb < RB; ++rb) {
            const int iq = w_lo + rb * 16 + fr;
            const float lt = xsum4(l[rb]);
            const float inv = 1.f / lt;
            bf16* orow = a.o + (long)iq * a.op + fq * 4;
            if (a.mode == 0) {
#pragma unroll
                for (int db = 0; db < 8; ++db) { v2u w; w.x = pk2(o[rb][db][0] * inv, o[rb][db][1] * inv); w.y = pk2(o[rb][db][2] * inv, o[rb][db][3] * inv); *(v2u*)(orow + db * 16) = w; }
            } else {
                float* lp = a.lse + (long)iq * a.lsep;
                float lse = m[rb] * LN2 + __logf(lt);
                float wn = inv, wo = 0.f;
                if (a.mode == 2) { const float lo = oldl[rb], mm = fmaxf(lo, lse), eo = __expf(lo - mm), en = __expf(lse - mm), den = eo + en; wo = eo / den; wn = en / den * inv; lse = mm + __logf(den); }
#pragma unroll
                for (int db = 0; db < 8; ++db) {
                    float r0 = o[rb][db][0] * wn, r1 = o[rb][db][1] * wn, r2 = o[rb][db][2] * wn, r3 = o[rb][db][3] * wn;
                    if (a.mode == 2) { const v2u old = oldo[rb][db]; r0 += wo * bf2f(old.x & 0xffffu); r1 += wo * bf2f(old.x >> 16); r2 += wo * bf2f(old.y & 0xffffu); r3 += wo * bf2f(old.y >> 16); }
                    v2u w; w.x = pk2(r0, r1); w.y = pk2(r2, r3); *(v2u*)(orow + db * 16) = w;
                }
                if (fq == 0) *lp = lse;
            }
        }
        a = nx; has = hasn;
    }
#undef ATT_LOAD
#undef ATT_BASE
#undef ATT_QLOAD
}
#define XB_TMO      128
#define XB_XCNT(j)  (256  + 64 * (j))
#define XB_XSUB(j)  (1280 + 64 * (j))
#define XB_XGEN(j)  (2304 + 64 * (j))
#define XB_TOP      3328
#define XB_TOPGEN   3392
#define XCD_BAR_WORDS 3456
#define XB_SPIN_CAP (1u << 18)

__device__ __forceinline__ unsigned xb_ld(unsigned* p)              { return __hip_atomic_load(p, __ATOMIC_RELAXED, __HIP_MEMORY_SCOPE_AGENT); }
__device__ __forceinline__ unsigned xb_add(unsigned* p, unsigned v) { return __hip_atomic_fetch_add(p, v, __ATOMIC_RELAXED, __HIP_MEMORY_SCOPE_AGENT); }
__device__ __forceinline__ unsigned xb_xcc_id() { return (unsigned)__builtin_amdgcn_s_getreg((3 << 11) | 20) & 0xFu; }
#define XB_SPIN(cond, bar) do { unsigned _sp = 0; while (cond) { __builtin_amdgcn_s_sleep(1); \
    if ((++_sp & 255u) == 0u) { if (xb_ld(&(bar)[XB_TMO])) break; if (_sp > XB_SPIN_CAP) { atomicAdd(&(bar)[XB_TMO], 1u); break; } } } } while (0)

struct XcdBarrier {
    unsigned* bar; unsigned x;
    volatile LAS unsigned* st;
};

__device__ __forceinline__ XcdBarrier xcd_barrier_post(unsigned* bar, volatile LAS unsigned* st) {
    XcdBarrier b; b.bar = bar; b.x = xb_xcc_id(); b.st = st;
    if (threadIdx.x == 0) (void)xb_add(&bar[XB_XCNT(b.x)], 1u);
    return b;
}
__device__ __forceinline__ void xcd_barrier_complete(unsigned* bar, unsigned x, unsigned& nloc, unsigned& nx) {
    const unsigned G = gridDim.x * gridDim.y * gridDim.z;
    unsigned sum, cnt, mine, sp = 0u;
    for (;;) {
        sum = 0u; cnt = 0u; mine = 0u;
#pragma unroll
        for (unsigned j = 0; j < 16; ++j) { const unsigned c = xb_ld(&bar[XB_XCNT(j)]); sum += c; cnt += (c > 0u) ? 1u : 0u; mine = (j == x) ? c : mine; }
        if (sum == G) break;
        __builtin_amdgcn_s_sleep(1);
        if ((++sp & 255u) == 0u) { if (xb_ld(&bar[XB_TMO])) break; if (sp > XB_SPIN_CAP) { atomicAdd(&bar[XB_TMO], 1u); break; } }
    }
    nloc = mine > 0u ? mine : 1u; nx = cnt > 0u ? cnt : 1u;
}

__device__ __forceinline__ void xcd_barrier(const XcdBarrier& b) {
    asm volatile("s_waitcnt vmcnt(0)" ::: "memory");
    __syncthreads();
    if (threadIdx.x == 0) {
        unsigned* bar = b.bar;
        __builtin_amdgcn_s_waitcnt(0);
        unsigned nloc = b.st[0], nx = b.st[1];
        if (nloc == 0u) { xcd_barrier_complete(bar, b.x, nloc, nx); b.st[0] = nloc; b.st[1] = nx; }
        const unsigned old = xb_add(&bar[XB_XSUB(b.x)], 1u);
        const unsigned gen = old / nloc;
        if (old + 1u == (gen + 1u) * nloc) {
            __builtin_amdgcn_fence(__ATOMIC_RELEASE, "agent");
            asm volatile("s_waitcnt vmcnt(0)" ::: "memory");
            const unsigned og = xb_add(&bar[XB_TOP], 1u);
            const unsigned tg = og / nx;
            if (og + 1u == (tg + 1u) * nx) xb_add(&bar[XB_TOPGEN], 1u);
            else XB_SPIN(xb_ld(&bar[XB_TOPGEN]) == tg, bar);
            __builtin_amdgcn_fence(__ATOMIC_ACQUIRE, "agent");
            xb_add(&bar[XB_XGEN(b.x)], 1u);
            asm volatile("s_waitcnt vmcnt(0)" ::: "memory");
        } else {
            XB_SPIN(xb_ld(&bar[XB_XGEN(b.x)]) == gen, bar);
            __builtin_amdgcn_fence(__ATOMIC_ACQUIRE, "agent");
            asm volatile("s_waitcnt vmcnt(0)" ::: "memory");
        }
    }
    __syncthreads();
}
template <class Epi, bool ALIGN = true, int WGMV = 4> __device__ __forceinline__ void run_gemm(LAS unsigned char* lds, const bf16* A, const bf16* Bt, int M, int N, int K, const Epi& E) {
    pg8::Gemm g{A, Bt, M, N, K}; pg8::StaticOrder S; S.init(M, N, (int)gridDim.x, (int)blockIdx.x, WGMV);
    pg8::gemm_phase<Epi, pg8::StaticOrder, ALIGN, true>(lds, g, S, E);
}


#define GAS __attribute__((address_space(1)))
__device__ __forceinline__ void* karg(int i) { typedef void* const volatile __attribute__((address_space(4))) * kargp_t; kargp_t ka = (kargp_t)__builtin_amdgcn_kernarg_segment_ptr(); void* q = ka[i]; return (void*)(GAS void*)q; }
#define INF(i) ((const float*)karg(i))
#define WSB(off) ((bf16*)((unsigned char*)karg(20) + (off)))
#define P_x INF(0)
#define P_positions ((const int*)karg(1))
#define P_mixer_norm INF(2)
#define P_ffn_norm INF(3)
#define P_mla_w_down INF(4)
#define P_mla_q_norm INF(5)
#define P_mla_kv_norm INF(6)
#define P_mla_w_uq INF(7)
#define P_mla_w_ukv INF(8)
#define P_mla_q_gain INF(9)
#define P_mla_k_gain INF(10)
#define P_mla_w_o INF(11)
#define P_dil_w_qkv INF(12)
#define P_dil_q_gain INF(13)
#define P_dil_k_gain INF(14)
#define P_dil_w_o INF(15)
#define P_ffn_w_gate INF(16)
#define P_ffn_w_up INF(17)
#define P_ffn_w_down INF(18)
#define P_out ((float*)karg(19))
#define P_Wqkv_t WSB(WS_WQKV)
#define P_Wd_t WSB(WS_WD)
#define P_Wuq_t WSB(WS_WUQ)
#define P_Wukv_t WSB(WS_WUKV)
#define P_Wo_t WSB(WS_WO)
#define P_Wgu_t WSB(WS_WGU)
#define P_Wdn_t WSB(WS_WDN)
#define P_H WSB(WS_H)
#define P_O WSB(WS_O)
#define P_LSE ((float*)WSB(WS_LSE))
#define P_DOWN WSB(WS_DOWN)
#define P_CQ WSB(WS_CQ)
#define P_CKV WSB(WS_CKV)
#define P_KROPE WSB(WS_KROPE)
#define P_QRAW WSB(WS_QRAW)
#define P_KVRAW WSB(WS_KVRAW)
#define P_ACT WSB(WS_A)
#define P_QKVG WSB(WS_QKVG)
__global__ void __launch_bounds__(NWAVES * 64, 2) fwd_kernel(Params p) {
    extern __shared__ __attribute__((aligned(16))) unsigned char lds_raw[];
    LAS unsigned char* lds = (LAS unsigned char*)lds_raw;
#define PHASE_IDS int tid_ = threadIdx.x; asm volatile("" : "+v"(tid_)); const int tid = tid_, lane = tid & 63, wave = __builtin_amdgcn_readfirstlane(tid >> 6); \
    const int G = gridDim.x, gw = blockIdx.x * NWAVES + wave, ngw = G * NWAVES; LAS float* scr = (LAS float*)(lds + wave * 16384); (void)scr; (void)gw; (void)ngw; (void)lane; (void)G;

    if (threadIdx.x < 32) ((LAS unsigned*)(lds + MISC_OFF))[threadIdx.x] = 0u;
    __syncthreads();
    XcdBarrier xbar = xcd_barrier_post((unsigned*)((unsigned char*)karg(20) + WS_BAR), (volatile LAS unsigned*)(lds + MISC_OFF) + 8);
#define GRID_SYNC() do { XcdBarrier b_; b_.bar = (unsigned*)((unsigned char*)karg(20) + WS_BAR); b_.x = xb_xcc_id(); b_.st = (volatile LAS unsigned*)(lds + MISC_OFF) + 8; xcd_barrier(b_); } while (0)
    (void)xbar;
    for (int layer = 0; layer < 2; ++layer) {
        { PHASE_IDS
        if (layer == 0) norm_rows(P_x, P_mixer_norm, P_H, gw, ngw, lane);
        if (layer == 0) {
            bf16* const wd_t = P_Wd_t;
            { float* const ssz = (float*)WSB(WS_SS); for (int i = blockIdx.x * 512 + tid; i < 2 * NTOK; i += G * 512) { float zz = 0.f; asm volatile("" : "+v"(zz)); ssz[i] = zz; } }
            { unsigned* const tm = (unsigned*)WSB(WS_MTAB); const int* const pos = P_positions; const float ifr = powf(10000.f, -2.f * (float)(lane & 31) / 64.f);
              for (int t2 = gw; t2 < NTOK / 2; t2 += ngw) { const int t = 2 * t2 + (lane >> 5); const float ang = (float)pos[t] * ifr; const int ci = (int)rintf(cosf(ang) * 32767.f), si = (int)rintf(sinf(ang) * 32767.f);
                  tm[(size_t)t * 32 + (lane & 31)] = ((unsigned)ci & 0xffffu) | ((unsigned)si << 16); } }
            conv_matrix<0>(P_mla_w_down, DM, DOWN_N, wd_t, 0, scr, gw, ngw, lane);
            for (int i = blockIdx.x * 512 + tid; i < (DOWN_NP - DOWN_N) * DM / 8; i += G * 512) { unsigned zz = 0u; asm volatile("" : "+v"(zz)); ((v4u*)(wd_t + (size_t)DOWN_N * DM))[i] = (v4u){zz, zz, zz, zz}; }
            conv_matrix<0>(P_mla_w_uq, 512, 3072, P_Wuq_t, 0, scr, gw, ngw, lane);
            conv_matrix<0>(P_mla_w_ukv, 512, 4096, P_Wukv_t, 0, scr, gw, ngw, lane);
        } else {
            conv_matrix<2>(P_dil_w_qkv, DM, 18432, P_Wqkv_t, 0, scr, gw, ngw, lane);
            { unsigned* const tb = (unsigned*)WSB(WS_COST); const int* const pos = P_positions; const float ifr = powf(10000.f, -2.f * (float)lane / 128.f);
              for (int t = gw; t < NTOK; t += ngw) { const float ang = (float)pos[t] * ifr; const int ci = (int)rintf(cosf(ang) * 32767.f), si = (int)rintf(sinf(ang) * 32767.f);
                  tb[(size_t)t * 64 + lane] = ((unsigned)ci & 0xffffu) | ((unsigned)si << 16); } }
            conv_matrix<0>(P_dil_w_o, DM, DM, P_Wo_t, 0, scr, gw, ngw, lane);
        }
        if (layer == 1) {
        conv_matrix<1, true>(P_ffn_w_gate + (size_t)DM * FF, DM, FF, P_Wgu_t, 0, scr, gw, ngw, lane, P_ffn_norm + DM);
        conv_matrix<1, true>(P_ffn_w_up + (size_t)DM * FF, DM, FF, P_Wgu_t, 1, scr, gw, ngw, lane, P_ffn_norm + DM);
        conv_matrix<0>(P_ffn_w_down + (size_t)DM * FF, FF, DM, P_Wdn_t, 0, scr, gw, ngw, lane);
        norm_rows(P_out, P_mixer_norm + DM, P_H, gw, ngw, lane);
        }
        }
        if (gridDim.x == 0x7fffffffu) cg::this_grid().sync();
        GRID_SYNC();

        if (layer == 0) {
            { pg8::EpiStoreBf16 E{P_DOWN, DOWN_NP}; run_gemm(lds, P_H, P_Wd_t, NTOK, DOWN_NP, DM, E); }
            { PHASE_IDS
              const bool shadow = (G == 256);
              if (!shadow || blockIdx.x >= 64) {
                  const int gw2 = shadow ? ((int)blockIdx.x - 64) * NWAVES + wave : gw, ngw2 = shadow ? 192 * NWAVES : ngw;
                  conv_matrix<0>(P_mla_w_o, DM, DM, P_Wo_t, 0, scr, gw2, ngw2, lane);
                  conv_matrix<1, true>(P_ffn_w_gate, DM, FF, P_Wgu_t, 0, scr, gw2, ngw2, lane, P_ffn_norm);
                  conv_matrix<1, true>(P_ffn_w_up, DM, FF, P_Wgu_t, 1, scr, gw2, ngw2, lane, P_ffn_norm);
                  conv_matrix<0>(P_ffn_w_down, FF, DM, P_Wdn_t, 0, scr, gw2, ngw2, lane);
              } }
            GRID_SYNC();
            { PHASE_IDS const bf16* const L_DOWN = P_DOWN; bf16* const L_CQ = P_CQ; bf16* const L_CKV = P_CKV; bf16* const L_KROPE = P_KROPE; const float* const L_mla_q_norm = P_mla_q_norm; const float* const L_mla_kv_norm = P_mla_kv_norm; const float* const L_mla_k_gain = P_mla_k_gain; const int* const L_positions = P_positions;
            const f32x4 ga0 = *(const f32x4*)(L_mla_q_norm + lane * 8), ga1 = *(const f32x4*)(L_mla_q_norm + lane * 8 + 4);
            const f32x4 gb0 = *(const f32x4*)(L_mla_kv_norm + lane * 8), gb1 = *(const f32x4*)(L_mla_kv_norm + lane * 8 + 4);
            const float gkr = L_mla_k_gain[128 + lane];
            const unsigned* const mtab = (const unsigned*)WSB(WS_MTAB);
            for (int t0 = gw; t0 < NTOK; t0 += 2 * ngw) {
                const int t1 = (t0 + ngw < NTOK) ? t0 + ngw : t0;
                s16x8 a8[2], b8[2]; float xr[2]; unsigned tw[2];
#pragma unroll
                for (int q = 0; q < 2; ++q) { const int t = q ? t1 : t0; const bf16* dr = L_DOWN + (size_t)t * DOWN_NP;
                    a8[q] = *(const s16x8*)(dr + lane * 8); b8[q] = *(const s16x8*)(dr + 512 + lane * 8); xr[q] = bf2f(dr[1024 + lane]); tw[q] = mtab[(size_t)t * 32 + (lane & 31)]; }
                float sa[2], sb[2], sr[2];
#pragma unroll
                for (int q = 0; q < 2; ++q) { sa[q] = 0.f; sb[q] = 0.f; sr[q] = xr[q] * xr[q];
#pragma unroll
                    for (int j = 0; j < 8; ++j) { const float fa = bf2f((unsigned short)a8[q][j]), fb = bf2f((unsigned short)b8[q][j]); sa[q] += fa * fa; sb[q] += fb * fb; } }
#pragma unroll
                for (int o = 1; o < 64; o <<= 1) {
#pragma unroll
                    for (int q = 0; q < 2; ++q) { sa[q] += shfl_xor_l(sa[q], o); sb[q] += shfl_xor_l(sb[q], o); sr[q] += shfl_xor_l(sr[q], o); } }
#pragma unroll
                for (int q = 0; q < 2; ++q) { const int t = q ? t1 : t0;
                    if (q == 1 && t1 == t0) break;
                    const float ra = rsqrtf(sa[q] * (1.f / 512) + EPS), rb = rsqrtf(sb[q] * (1.f / 512) + EPS), rr = rsqrtf(sr[q] * (1.f / 64) + EPS);
                    float fa[8], fb[8];
#pragma unroll
                    for (int j = 0; j < 8; ++j) { fa[j] = bf2f((unsigned short)a8[q][j]) * ra; fb[j] = bf2f((unsigned short)b8[q][j]) * rb; }
                    v4u wa, wb;
                    wa.x = pk2(fa[0] * ga0.x, fa[1] * ga0.y); wa.y = pk2(fa[2] * ga0.z, fa[3] * ga0.w); wa.z = pk2(fa[4] * ga1.x, fa[5] * ga1.y); wa.w = pk2(fa[6] * ga1.z, fa[7] * ga1.w);
                    wb.x = pk2(fb[0] * gb0.x, fb[1] * gb0.y); wb.y = pk2(fb[2] * gb0.z, fb[3] * gb0.w); wb.z = pk2(fb[4] * gb1.x, fb[5] * gb1.y); wb.w = pk2(fb[6] * gb1.z, fb[7] * gb1.w);
                    *(v4u*)(L_CQ + (size_t)t * 512 + lane * 8) = wa; *(v4u*)(L_CKV + (size_t)t * 512 + lane * 8) = wb;
                    const float y = xr[q] * rr * gkr, pr = shfl_xor_l(y, 32);
                    const float cs = (float)((int)(tw[q] << 16) >> 16) * (1.f / 32767.f), sn = (float)((int)tw[q] >> 16) * (1.f / 32767.f);
                    L_KROPE[(size_t)t * 64 + lane] = (bf16)f2bf(lane < 32 ? y * cs - pr * sn : y * cs + pr * sn);
                }
            } }
            GRID_SYNC();
            { pg8::EpiStoreBf16 E{P_QRAW, 3072}; run_gemm(lds, P_CQ, P_Wuq_t, NTOK, 3072, 512, E); }
            { pg8::EpiKVNorm E{P_KVRAW, 4096, P_mla_k_gain, (unsigned)(__SIZE_TYPE__)(lds + EX_OFF)}; run_gemm(lds, P_CKV, P_Wukv_t, NTOK, 4096, 512, E); }
            GRID_SYNC();
            { PHASE_IDS const bf16* const L_QRAW = P_QRAW; const bf16* const L_KVRAW = P_KVRAW; const bf16* const L_KROPE = P_KROPE; bf16* const L_O = P_O;
            struct MlaSched { const bf16* QR; const bf16* KV; const bf16* KR; bf16* OO; int c; const unsigned* TB; const float* QG;
                __device__ __forceinline__ bool get(int it, AttnArgs& a) const {
                    if (it >= 4 || c >= 256) return false;
                    const int bh = c & 127, half = (c >> 7) & 1, b = bh >> 4, h = bh & 15;
                    const int qb = half ? (it == 0 ? 6 : it == 1 ? 5 : it == 2 ? 2 : 1) : (it == 0 ? 7 : it == 1 ? 4 : it == 2 ? 3 : 0), q0 = qb * 256; const size_t tok0 = (size_t)b * SEQ + q0;
                    a.q = QR + tok0 * 3072 + h * 192; a.qp = 3072; a.k = KV + tok0 * 4096 + h * 256; a.kp = 4096; a.k2 = KR + tok0 * 64; a.k2p = 64;
                    a.v = KV + tok0 * 4096 + h * 256 + 128; a.vp = 4096; a.o = OO + tok0 * DM + h * 128; a.op = DM; a.lse = nullptr; a.lsep = 0;
                    a.cstart = -q0; a.nt = (q0 + 256) / 64; a.W = 1 << 24; a.mode = 0; a.qtab = TB + tok0 * 32; a.qgain = QG; return true; } };
            const MlaSched S{L_QRAW, L_KVRAW, L_KROPE, L_O, (int)blockIdx.x, (const unsigned*)WSB(WS_MTAB), P_mla_q_gain};
            attn_phase<192, 2, false, true, MlaSched>(lds, S, tid, wave, lane); }
            __syncthreads();
            GRID_SYNC();
        } else {
            for (int g = 0; g < 3; ++g) {
                { pg8::EpiQKRope E{P_QKVG, 6144, (const unsigned*)WSB(WS_COST), P_dil_q_gain + g * 128, P_dil_k_gain + g * 128, QSCALE_DIL, (unsigned)(__SIZE_TYPE__)(lds + EX_OFF)}; run_gemm(lds, P_H, P_Wqkv_t + (size_t)g * 6144 * DM, NTOK, 6144, DM, E); }
                GRID_SYNC();
                { PHASE_IDS const bf16* const L_QKVG = P_QKVG; bf16* const L_O = P_O; float* const L_LSE = P_LSE; const float* const L_COST = (const float*)WSB(WS_COST); const float* const L_SINT = (const float*)WSB(WS_SINT); const float* const L_dil_q_gain = P_dil_q_gain; const float* const L_dil_k_gain = P_dil_k_gain;
                struct DilSched { const bf16* QKV; bf16* OO; float* LS; int c, G, dl, nbk, mode;
                    __device__ __forceinline__ bool get(int i, AttnArgs& a) const {
                        const int u = c + i * G; if (u >= 2048) return false;
                        const int bh = u & 127, sub = u >> 7, b = bh >> 4, h = bh & 15, r = sub / nbk, blk = sub - r * nbk, i0 = blk * 128; const size_t tok0 = (size_t)b * SEQ + r + (size_t)dl * i0;
                        a.q = QKV + tok0 * 6144 + h * 128; a.qp = (long)dl * 6144; a.k = a.q + 2048; a.kp = a.qp; a.k2 = nullptr; a.k2p = 0; a.v = a.q + 4096; a.vp = a.qp;
                        a.o = OO + tok0 * DM + h * 128; a.op = (long)dl * DM; a.lse = LS + tok0 * 16 + h; a.lsep = (long)dl * 16;
                        a.cstart = blk == 0 ? 0 : -128; a.nt = blk == 0 ? 2 : 4; a.W = 128; a.mode = mode; a.qtab = nullptr; a.qgain = nullptr; return true; } };
                const int dl = (g == 0) ? 1 : (g == 1 ? 4 : 16);
                const DilSched S{L_QKVG, L_O, L_LSE, (int)blockIdx.x, G, dl, 16 / dl, g == 0 ? 1 : 2};
                attn_phase<128, 1, true, false, DilSched>(lds, S, tid, wave, lane); }
                __syncthreads();
                GRID_SYNC();
            }
        }
        { pg8::EpiResF32Stat E{layer == 0 ? P_x : P_out, P_out, DM, P_H, (float*)WSB(WS_SS) + layer * NTOK}; run_gemm(lds, P_O, P_Wo_t, NTOK, DM, DM, E); }
        GRID_SYNC();
        { pg8::EpiSwiGLU E{P_ACT, FF, (const float*)WSB(WS_SS) + layer * NTOK}; run_gemm(lds, P_H, P_Wgu_t, NTOK, 2 * FF, DM, E); }
        GRID_SYNC();
        { pg8::EpiResF32 E{P_out, P_out, DM}; run_gemm<pg8::EpiResF32, true, 2>(lds, P_ACT, P_Wdn_t, NTOK, DM, FF, E); }
        GRID_SYNC();
    }
}

#undef P_x
#undef P_positions
#undef P_mixer_norm
#undef P_ffn_norm
#undef P_mla_w_down
#undef P_mla_q_norm
#undef P_mla_kv_norm
#undef P_mla_w_uq
#undef P_mla_w_ukv
#undef P_mla_q_gain
#undef P_mla_k_gain
#undef P_mla_w_o
#undef P_dil_w_qkv
#undef P_dil_q_gain
#undef P_dil_k_gain
#undef P_dil_w_o
#undef P_ffn_w_gate
#undef P_ffn_w_up
#undef P_ffn_w_down
#undef P_out
#undef P_Wqkv_t
#undef P_Wd_t
#undef P_Wuq_t
#undef P_Wukv_t
#undef P_Wo_t
#undef P_Wgu_t
#undef P_Wdn_t
#undef P_H
#undef P_O
#undef P_LSE
#undef P_DOWN
#undef P_CQ
#undef P_CKV
#undef P_KROPE
#undef P_QRAW
#undef P_KVRAW
#undef P_ACT
#undef P_QKVG
extern "C" void kernel_launch(void* const* d_in, const int* in_sizes, int n_in, void* d_out, int out_size, void* d_ws, size_t ws_size, hipStream_t stream) {
    static int grid_blocks = 0;
    if (grid_blocks == 0) {
        if (n_in != 19 || ws_size < WS_END) { fprintf(stderr, "kernel_launch: expected 19 inputs and >= %zu bytes of workspace; got %d inputs, %zu bytes\n", (size_t)WS_END, n_in, ws_size); grid_blocks = -1; return; }
        int dev = 0, cus = 0, per_cu = 0;
        hipGetDevice(&dev);
        hipDeviceGetAttribute(&cus, hipDeviceAttributeMultiprocessorCount, dev);
        if (hipFuncSetAttribute((const void*)fwd_kernel, hipFuncAttributeMaxDynamicSharedMemorySize, LDS_BYTES) != hipSuccess) fprintf(stderr, "kernel_launch: hipFuncSetAttribute failed\n");
        if (hipOccupancyMaxActiveBlocksPerMultiprocessor(&per_cu, (const void*)fwd_kernel, NWAVES * 64, LDS_BYTES) != hipSuccess || per_cu < 1) { fprintf(stderr, "kernel_launch: occupancy query says %d blocks per CU; using 1\n", per_cu); per_cu = 1; }
        (void)hipGetLastError();
        grid_blocks = cus * per_cu;
    }
    if (grid_blocks < 0) return;
    if (hipMemsetAsync((unsigned char*)d_ws + WS_BAR, 0, XCD_BAR_WORDS * 4, stream) != hipSuccess) fprintf(stderr, "kernel_launch: hipMemsetAsync failed\n");
    Params p{};
    for (int i = 0; i < 19; ++i) p.in[i] = d_in[i];
    p.out = (float*)d_out; p.ws = (unsigned char*)d_ws;
    void* args[] = {&p};
    const hipError_t e = hipLaunchCooperativeKernel((const void*)fwd_kernel, dim3(grid_blocks), dim3(NWAVES * 64), args, LDS_BYTES, stream);
    if (e != hipSuccess) fprintf(stderr, "kernel_launch: cooperative launch failed: %s (grid %d)\n", hipGetErrorString(e), grid_blocks);
}
```

```cpp
#include <hip/hip_runtime.h>
#include <hip/hip_cooperative_groups.h>
#include <cstdio>
#include <cstdint>
namespace cg = cooperative_groups;
namespace pg8 {
#define PG8_LAS __attribute__((address_space(3)))
typedef unsigned short bf16_t;
typedef short bf16x8 __attribute__((ext_vector_type(8)));
typedef float f32x4 __attribute__((ext_vector_type(4)));
typedef unsigned u32x4 __attribute__((ext_vector_type(4)));
constexpr int BM = 256, BK = 64, HALF = 128, HTB = HALF * BK * 2  , STAGE_BYTES = 8 * HTB, NXCD = 8, WGM = 4;

__host__ __device__ __forceinline__ int lds_byte(int r, int c) { const int st = (r >> 4) * 2 + (c >> 5), rr = r & 15, cc = c & 31, ob = rr * 64 + cc * 2; return st * 1024 + (ob ^ (((ob >> 9) & 1) << 5)); }
__host__ __device__ __forceinline__ void stage_rc(int b, int& R, int& C) { const int st = b / 1024, sb = b % 1024, swz = sb ^ (((sb >> 9) & 1) << 5); R = (st >> 1) * 16 + swz / 64; C = (st & 1) * 32 + (swz % 64) / 2; }
__host__ __device__ __forceinline__ int perm32(int rho) { const int n = rho >> 4, i = rho & 15; return 8 * (i >> 2) + 4 * n + (i & 3); }

struct Unit { int pm, pn; };
struct Gemm { const bf16_t* A; const bf16_t* Bt; int M, N, K; };

struct StaticOrder {
    int nM, nN, nwg, G, c, wgm;
    __host__ __device__ void init(int M, int N, int G_, int c_, int wgm_ = WGM) { nM = M / BM; nN = N / BM; nwg = nM * nN; G = G_; c = c_; wgm = wgm_; }
    __host__ __device__ bool next(int i, Unit& u) const {
        const long L = (long)i * G + c; if (L >= nwg) return false;
        int wgid = (int)L; { const int q = nwg / NXCD, r = nwg % NXCD, xcd = wgid % NXCD, off = wgid / NXCD; wgid = (xcd < r ? xcd * (q + 1) : r * (q + 1) + (xcd - r) * q) + off; }
        const int nig = wgm * nN, gid = wgid / nig, fm = gid * wgm, gsz = (nM - fm) < wgm ? (nM - fm) : wgm;
        u.pm = fm + ((wgid % nig) % gsz); u.pn = (wgid % nig) / gsz; return true;
    }
    __device__ __forceinline__ void a_ready(const Unit&) const {}
    __device__ __forceinline__ void done(const Unit&) const {}
};
__device__ __forceinline__ unsigned cvt_pk_bf16(float lo, float hi) { unsigned r; asm volatile("v_cvt_pk_bf16_f32 %0, %1, %2" : "=v"(r) : "v"(lo), "v"(hi)); return r; }
typedef float f32x2 __attribute__((ext_vector_type(2)));
struct EpiStoreBf16 {
    static constexpr bool PERM = true, AFTER_DRAIN = false;
    bf16_t* O; int ldc;
    __device__ __forceinline__ void operator()(const f32x4 (&acc)[2][2][4][2], const Unit& u, int wr, int wc, int fr, int fq) const {
        const int row0 = u.pm * BM + wr * 64 + fr, col0 = u.pn * BM + wc * 32 + 8 * fq;
#pragma unroll
        for (int ai = 0; ai < 2; ++ai)
#pragma unroll
            for (int m = 0; m < 4; ++m) { bf16_t* rowp = O + (size_t)(row0 + ai * HALF + m * 16) * ldc + col0;
#pragma unroll
                for (int bj = 0; bj < 2; ++bj) { const f32x4 v0 = acc[ai][bj][m][0], v1 = acc[ai][bj][m][1];
                    u32x4 w; w.x = cvt_pk_bf16(v0[0], v0[1]); w.y = cvt_pk_bf16(v0[2], v0[3]); w.z = cvt_pk_bf16(v1[0], v1[1]); w.w = cvt_pk_bf16(v1[2], v1[3]);
                    *(u32x4*)(rowp + bj * HALF) = w; } }
    }
};
struct EpiResF32 {
    static constexpr bool PERM = true, AFTER_DRAIN = false;
    const float* base; float* out; int ldc;
    __device__ __forceinline__ void operator()(const f32x4 (&acc)[2][2][4][2], const Unit& u, int wr, int wc, int fr, int fq) const {
        const int row0 = u.pm * BM + wr * 64 + fr, col0 = u.pn * BM + wc * 32 + 8 * fq;
#pragma unroll
        for (int ai = 0; ai < 2; ++ai)
#pragma unroll
            for (int m = 0; m < 4; ++m) { const size_t off = (size_t)(row0 + ai * HALF + m * 16) * ldc + col0;
#pragma unroll
                for (int bj = 0; bj < 2; ++bj)
#pragma unroll
                    for (int n = 0; n < 2; ++n) { const f32x4 b = *(const f32x4*)(base + off + bj * HALF + 4 * n);
                        *(f32x4*)(out + off + bj * HALF + 4 * n) = b + acc[ai][bj][m][n]; } }
    }
};
struct EpiSwiGLU {
    static constexpr bool PERM = true, AFTER_DRAIN = false;
    bf16_t* O; int ldc; const float* ss;
    static __device__ __forceinline__ float sw(float g, float up) { return g * __builtin_amdgcn_rcpf(1.f + __expf(-g)) * up; }
    __device__ __forceinline__ void operator()(const f32x4 (&acc)[2][2][4][2], const Unit& u, int wr, int wc, int fr, int fq) const {
        const int row0 = u.pm * BM + wr * 64 + fr, col0 = u.pn * HALF + wc * 32 + 8 * fq;
#pragma unroll
        for (int ai = 0; ai < 2; ++ai)
#pragma unroll
            for (int m = 0; m < 4; ++m) { bf16_t* rowp = O + (size_t)(row0 + ai * HALF + m * 16) * ldc + col0;
                const float rstd = rsqrtf(ss[row0 + ai * HALF + m * 16] * (1.f / 2048) + 1e-6f);
                const f32x4 g0 = acc[ai][0][m][0] * rstd, g1 = acc[ai][0][m][1] * rstd, u0 = acc[ai][1][m][0] * rstd, u1 = acc[ai][1][m][1] * rstd;
                u32x4 w; w.x = cvt_pk_bf16(sw(g0[0], u0[0]), sw(g0[1], u0[1])); w.y = cvt_pk_bf16(sw(g0[2], u0[2]), sw(g0[3], u0[3]));
                w.z = cvt_pk_bf16(sw(g1[0], u1[0]), sw(g1[1], u1[1])); w.w = cvt_pk_bf16(sw(g1[2], u1[2]), sw(g1[3], u1[3]));
                *(u32x4*)rowp = w; }
    }
};

struct EpiQKRope {
    static constexpr bool PERM = true, AFTER_DRAIN = false;
    bf16_t* O; int ldc; const unsigned* tab; const float* qgain; const float* kgain; float qscale; unsigned exb;
    __device__ __forceinline__ void operator()(const f32x4 (&acc)[2][2][4][2], const Unit& u, int wr, int wc, int fr_in, int fq_in) const {
        int fr = fr_in, fq = fq_in; asm volatile("" : "+v"(fr), "+v"(fq));
        const int row0 = u.pm * BM + wr * 64 + fr;
        if (u.pn >= 16) {
            const int col0 = u.pn * BM + wc * 32 + 8 * fq;
#pragma unroll
            for (int ai = 0; ai < 2; ++ai)
#pragma unroll
                for (int m = 0; m < 4; ++m) { bf16_t* rowp = O + (size_t)(row0 + ai * HALF + m * 16) * ldc + col0;
#pragma unroll
                    for (int bj = 0; bj < 2; ++bj) { const f32x4 v0 = acc[ai][bj][m][0], v1 = acc[ai][bj][m][1];
                        u32x4 w; w.x = cvt_pk_bf16(v0[0], v0[1]); w.y = cvt_pk_bf16(v0[2], v0[3]); w.z = cvt_pk_bf16(v1[0], v1[1]); w.w = cvt_pk_bf16(v1[2], v1[3]);
                        *(u32x4*)(rowp + bj * HALF) = w; } }
            return;
        }
        const int d0 = 16 * wc + 4 * fq;
        const unsigned xa = exb + 4096u * wr + 16u * fr;
        const unsigned wa = xa + 4u * wc;
#pragma unroll
        for (int ai = 0; ai < 2; ++ai)
#pragma unroll
            for (int m = 0; m < 4; ++m)
#pragma unroll
                for (int bj = 0; bj < 2; ++bj) { const f32x4 v0 = acc[ai][bj][m][0], v1 = acc[ai][bj][m][1];
                    float s = (v0[0] * v0[0] + v0[1] * v0[1]) + (v0[2] * v0[2] + v0[3] * v0[3]) + (v1[0] * v1[0] + v1[1] * v1[1]) + (v1[2] * v1[2] + v1[3] * v1[3]);
                    { float a_ = s, b_ = s; asm volatile("s_nop 1\n\tv_permlane16_swap_b32 %0, %1" : "+v"(a_), "+v"(b_)); a_ += b_; b_ = a_; asm volatile("s_nop 1\n\tv_permlane32_swap_b32 %0, %1" : "+v"(a_), "+v"(b_)); s = a_ + b_; }
                    if (fq == 0) asm volatile("ds_write_b32 %0, %1 offset:%2" :: "v"(wa), "v"(s), "n"(2048 * ai + 512 * m + 256 * bj) : "memory"); }
        u32x4 cs[2][4];
#pragma unroll
        for (int m = 0; m < 4; ++m) cs[0][m] = *(const u32x4*)(tab + (size_t)(row0 + m * 16) * 64 + d0);
        asm volatile("s_waitcnt lgkmcnt(0)" ::: "memory");
        __builtin_amdgcn_s_barrier();
        float rs[2][4][2];
#pragma unroll
        for (int ai = 0; ai < 2; ++ai)
#pragma unroll
            for (int m = 0; m < 4; ++m) { f32x4 p0, p1;
                asm volatile("ds_read_b128 %0, %2 offset:%3\n\tds_read_b128 %1, %2 offset:%4\n\ts_waitcnt lgkmcnt(0)" : "=&v"(p0), "=&v"(p1) : "v"(xa), "n"(2048 * ai + 512 * m), "n"(2048 * ai + 512 * m + 256) : "memory");
                rs[ai][m][0] = rsqrtf(((p0[0] + p0[1]) + (p0[2] + p0[3])) * (1.f / 128) + 1e-6f); rs[ai][m][1] = rsqrtf(((p1[0] + p1[1]) + (p1[2] + p1[3])) * (1.f / 128) + 1e-6f); }
#pragma unroll
        for (int m = 0; m < 4; ++m) cs[1][m] = *(const u32x4*)(tab + (size_t)(row0 + HALF + m * 16) * 64 + d0);
        const bool isq = u.pn < 8; const float* gain = isq ? qgain : kgain; const float sc = isq ? qscale : 1.f;
        const f32x4 g1 = *(const f32x4*)(gain + d0), g2 = *(const f32x4*)(gain + d0 + 64);
#pragma unroll
        for (int ai = 0; ai < 2; ++ai)
#pragma unroll
            for (int m = 0; m < 4; ++m) { const size_t tok = (size_t)(row0 + ai * HALF + m * 16);
                const u32x4 cw = cs[ai][m];
                f32x4 c4, s4;
                c4.x = (float)((int)(cw.x << 16) >> 16); c4.y = (float)((int)(cw.y << 16) >> 16); c4.z = (float)((int)(cw.z << 16) >> 16); c4.w = (float)((int)(cw.w << 16) >> 16);
                s4.x = (float)((int)cw.x >> 16); s4.y = (float)((int)cw.y >> 16); s4.z = (float)((int)cw.z >> 16); s4.w = (float)((int)cw.w >> 16);
                c4 = c4 * (1.f / 32767.f); s4 = s4 * (1.f / 32767.f);
                bf16_t* rowp = O + tok * ldc + u.pn * BM + d0;
#pragma unroll
                for (int bj = 0; bj < 2; ++bj) { const float r = rs[ai][m][bj];
                    const f32x4 y1 = acc[ai][bj][m][0] * r * g1, y2 = acc[ai][bj][m][1] * r * g2;
                    const f32x4 o1 = (y1 * c4 - y2 * s4) * sc, o2 = (y2 * c4 + y1 * s4) * sc;
                    typedef unsigned u32x2 __attribute__((ext_vector_type(2)));
                    u32x2 w1, w2; w1.x = cvt_pk_bf16(o1[0], o1[1]); w1.y = cvt_pk_bf16(o1[2], o1[3]); w2.x = cvt_pk_bf16(o2[0], o2[1]); w2.y = cvt_pk_bf16(o2[2], o2[3]);
                    *(u32x2*)(rowp + bj * HALF) = w1; *(u32x2*)(rowp + bj * HALF + 64) = w2; } }
    }
};

struct EpiKVNorm {
    static constexpr bool PERM = true, AFTER_DRAIN = false;
    bf16_t* O; int ldc; const float* kgain; unsigned exb;
    __device__ __forceinline__ void operator()(const f32x4 (&acc)[2][2][4][2], const Unit& u, int wr, int wc, int fr_in, int fq_in) const {
        int fr = fr_in, fq = fq_in; asm volatile("" : "+v"(fr), "+v"(fq));
        const int row0 = u.pm * BM + wr * 64 + fr, col0 = u.pn * BM + wc * 32 + 8 * fq;
        const unsigned xa = exb + 2048u * wr + 16u * fr, wa = xa + 4u * wc;
#pragma unroll
        for (int ai = 0; ai < 2; ++ai)
#pragma unroll
            for (int m = 0; m < 4; ++m) { const f32x4 v0 = acc[ai][0][m][0], v1 = acc[ai][0][m][1];
                float s = (v0[0] * v0[0] + v0[1] * v0[1]) + (v0[2] * v0[2] + v0[3] * v0[3]) + (v1[0] * v1[0] + v1[1] * v1[1]) + (v1[2] * v1[2] + v1[3] * v1[3]);
                { float a_ = s, b_ = s; asm volatile("s_nop 1\n\tv_permlane16_swap_b32 %0, %1" : "+v"(a_), "+v"(b_)); a_ += b_; b_ = a_; asm volatile("s_nop 1\n\tv_permlane32_swap_b32 %0, %1" : "+v"(a_), "+v"(b_)); s = a_ + b_; }
                if (fq == 0) asm volatile("ds_write_b32 %0, %1 offset:%2" :: "v"(wa), "v"(s), "n"(1024 * ai + 256 * m) : "memory"); }
#pragma unroll
        for (int ai = 0; ai < 2; ++ai)
#pragma unroll
            for (int m = 0; m < 4; ++m) { const f32x4 v0 = acc[ai][1][m][0], v1 = acc[ai][1][m][1];
                u32x4 w; w.x = cvt_pk_bf16(v0[0], v0[1]); w.y = cvt_pk_bf16(v0[2], v0[3]); w.z = cvt_pk_bf16(v1[0], v1[1]); w.w = cvt_pk_bf16(v1[2], v1[3]);
                *(u32x4*)(O + (size_t)(row0 + ai * HALF + m * 16) * ldc + col0 + HALF) = w; }
        asm volatile("s_waitcnt lgkmcnt(0)" ::: "memory");
        __builtin_amdgcn_s_barrier();
        const f32x4 g0 = *(const f32x4*)(kgain + wc * 32 + 8 * fq), g1 = *(const f32x4*)(kgain + wc * 32 + 8 * fq + 4);
#pragma unroll
        for (int ai = 0; ai < 2; ++ai)
#pragma unroll
            for (int mp = 0; mp < 2; ++mp) { f32x4 p0, p1;
                asm volatile("ds_read_b128 %0, %2 offset:%3\n\tds_read_b128 %1, %2 offset:%4\n\ts_waitcnt lgkmcnt(0)" : "=&v"(p0), "=&v"(p1) : "v"(xa), "n"(1024 * ai + 512 * mp), "n"(1024 * ai + 512 * mp + 256) : "memory");
                const float r0 = rsqrtf(((p0[0] + p0[1]) + (p0[2] + p0[3])) * (1.f / 128) + 1e-6f), r1 = rsqrtf(((p1[0] + p1[1]) + (p1[2] + p1[3])) * (1.f / 128) + 1e-6f);
                { const int m = 2 * mp; const f32x4 v0 = acc[ai][0][m][0] * r0 * g0, v1 = acc[ai][0][m][1] * r0 * g1;
                  u32x4 w; w.x = cvt_pk_bf16(v0[0], v0[1]); w.y = cvt_pk_bf16(v0[2], v0[3]); w.z = cvt_pk_bf16(v1[0], v1[1]); w.w = cvt_pk_bf16(v1[2], v1[3]);
                  *(u32x4*)(O + (size_t)(row0 + ai * HALF + m * 16) * ldc + col0) = w; }
                { const int m = 2 * mp + 1; const f32x4 v0 = acc[ai][0][m][0] * r1 * g0, v1 = acc[ai][0][m][1] * r1 * g1;
                  u32x4 w; w.x = cvt_pk_bf16(v0[0], v0[1]); w.y = cvt_pk_bf16(v0[2], v0[3]); w.z = cvt_pk_bf16(v1[0], v1[1]); w.w = cvt_pk_bf16(v1[2], v1[3]);
                  *(u32x4*)(O + (size_t)(row0 + ai * HALF + m * 16) * ldc + col0) = w; } }
    }
};

struct EpiResF32Stat {
    static constexpr bool PERM = true, AFTER_DRAIN = false;
    const float* base; float* out; int ldc; bf16_t* xb; float* ss;
    __device__ __forceinline__ void operator()(const f32x4 (&acc)[2][2][4][2], const Unit& u, int wr, int wc, int fr, int fq) const {
        const int row0 = u.pm * BM + wr * 64 + fr, col0 = u.pn * BM + wc * 32 + 8 * fq;
#pragma unroll
        for (int ai = 0; ai < 2; ++ai)
#pragma unroll
            for (int m = 0; m < 4; ++m) { const int row = row0 + ai * HALF + m * 16; const size_t off = (size_t)row * ldc + col0; float s = 0.f;
#pragma unroll
                for (int bj = 0; bj < 2; ++bj) { const f32x4 v0 = *(const f32x4*)(base + off + bj * HALF) + acc[ai][bj][m][0], v1 = *(const f32x4*)(base + off + bj * HALF + 4) + acc[ai][bj][m][1];
                    *(f32x4*)(out + off + bj * HALF) = v0; *(f32x4*)(out + off + bj * HALF + 4) = v1;
                    u32x4 w; w.x = cvt_pk_bf16(v0[0], v0[1]); w.y = cvt_pk_bf16(v0[2], v0[3]); w.z = cvt_pk_bf16(v1[0], v1[1]); w.w = cvt_pk_bf16(v1[2], v1[3]);
                    *(u32x4*)(xb + off + bj * HALF) = w;
                    s += (v0[0] * v0[0] + v0[1] * v0[1]) + (v0[2] * v0[2] + v0[3] * v0[3]) + (v1[0] * v1[0] + v1[1] * v1[1]) + (v1[2] * v1[2] + v1[3] * v1[3]); }
                { float a_ = s, b_ = s; asm volatile("s_nop 1\n\tv_permlane16_swap_b32 %0, %1" : "+v"(a_), "+v"(b_)); a_ += b_; b_ = a_; asm volatile("s_nop 1\n\tv_permlane32_swap_b32 %0, %1" : "+v"(a_), "+v"(b_)); s = a_ + b_; }
                if (fq == 0) __hip_atomic_fetch_add(ss + row, s, __ATOMIC_RELAXED, __HIP_MEMORY_SCOPE_AGENT); }
    }
};
template <class Epi, class Sched, bool ALIGN_EPI = false, bool SP2 = false>
__device__ __forceinline__ void gemm_phase(PG8_LAS unsigned char* lds, const Gemm g, const Sched& S, const Epi& E) {
    int tid_ = threadIdx.x; asm volatile("" : "+v"(tid_));
    const int tid = tid_, wid = __builtin_amdgcn_readfirstlane(tid >> 6), lane = tid & 63, wr = wid >> 2, wc = wid & 3, fr = lane & 15, fq = lane >> 4;
    const int K = g.K, nt = K / BK;
    unsigned voffA[2], voffB[2];
#pragma unroll
    for (int i = 0; i < 2; ++i) { int R, C; stage_rc(tid * 16 + i * 8192, R, C); const int Rb = Epi::PERM ? ((R & ~31) + perm32(R & 31)) : R;
        voffA[i] = (unsigned)(R * K + C) * 2u; voffB[i] = (unsigned)(Rb * K + C) * 2u; }
    const size_t kstep = (size_t)(BK * 2);
    const size_t hstep = (size_t)HALF * K * 2;
    const size_t tstep = 2 * hstep;
    const unsigned ldsw = (unsigned)wid * 1024u;
    const int aoff = lds_byte(wr * 64 + fr, fq * 8), boff = lds_byte(wc * 32 + fr, fq * 8);
#define PG8_SA(b, h) (((b) * 2 + (h)) * HTB)
#define PG8_SB(b, h) ((4 + (b) * 2 + (h)) * HTB)
#define PG8_STAGE(bufoff, gbase, voff) do { _Pragma("unroll") for (int _i = 0; _i < 2; ++_i) \
        __builtin_amdgcn_global_load_lds((const unsigned*)((const char*)(gbase) + (voff)[_i]), (PG8_LAS unsigned*)(lds + (bufoff) + ldsw + _i * 8192), 16, 0, 0); } while (0)
#define PG8_LDA(dst, b, h) do { _Pragma("unroll") for (int m = 0; m < 4; ++m) _Pragma("unroll") for (int k = 0; k < 2; ++k) dst[m][k] = *(const PG8_LAS bf16x8*)(lds + PG8_SA(b, h) + aoff + m * 2048 + k * 1024); } while (0)
#define PG8_LDB(dst, b, h) do { _Pragma("unroll") for (int n = 0; n < 2; ++n) _Pragma("unroll") for (int k = 0; k < 2; ++k) dst[n][k] = *(const PG8_LAS bf16x8*)(lds + PG8_SB(b, h) + boff + n * 2048 + k * 1024); } while (0)
#define PG8_MMA(ai, bj, At, Bt) do { __builtin_amdgcn_s_setprio(1); _Pragma("unroll") for (int m = 0; m < 4; ++m) _Pragma("unroll") for (int n = 0; n < 2; ++n) _Pragma("unroll") for (int k = 0; k < 2; ++k) \
        acc[ai][bj][m][n] = __builtin_amdgcn_mfma_f32_16x16x32_bf16(Bt[n][k], At[m][k], acc[ai][bj][m][n], 0, 0, 0); __builtin_amdgcn_s_setprio(0); } while (0)
#define PG8_WAIT_V(n) asm volatile("s_waitcnt vmcnt(" #n ")" ::: "memory")
#define PG8_WAIT_L(n) asm volatile("s_waitcnt lgkmcnt(" #n ")" ::: "memory")
#define PG8_BAR __builtin_amdgcn_s_barrier()
#define PG8_SCHED __builtin_amdgcn_sched_barrier(0)
    Unit cur, nxt; int ui = 0;
    if (!S.next(0, cur)) return;
    f32x4 acc[2][2][4][2];
#pragma unroll
    for (int a = 0; a < 2; ++a)
#pragma unroll
        for (int b = 0; b < 2; ++b)
#pragma unroll
            for (int m = 0; m < 4; ++m)
#pragma unroll
                for (int n = 0; n < 2; ++n) acc[a][b][m][n] = (f32x4){0.f, 0.f, 0.f, 0.f};
    bf16x8 At[4][2], B0[2][2], B1[2][2];
    const char* cA = (const char*)g.A + (size_t)cur.pm * tstep; const char* cB = (const char*)g.Bt + (size_t)cur.pn * tstep;
    S.a_ready(cur);
    if constexpr (SP2) {
        PG8_STAGE(PG8_SB(0, 0), cB, voffB); PG8_STAGE(PG8_SB(0, 1), cB + hstep, voffB); PG8_STAGE(PG8_SA(0, 0), cA, voffA); PG8_STAGE(PG8_SA(0, 1), cA + hstep, voffA);
        if (wr == 1) PG8_BAR;
        PG8_WAIT_V(2); PG8_BAR;
        PG8_STAGE(PG8_SB(1, 0), cB + kstep, voffB); PG8_STAGE(PG8_SA(1, 0), cA + kstep, voffA); PG8_STAGE(PG8_SB(1, 1), cB + hstep + kstep, voffB);
        PG8_WAIT_V(6); PG8_BAR;
    } else {
        PG8_STAGE(PG8_SB(0, 0), cB, voffB); PG8_STAGE(PG8_SA(0, 0), cA, voffA); PG8_STAGE(PG8_SB(0, 1), cB + hstep, voffB); PG8_STAGE(PG8_SA(0, 1), cA + hstep, voffA);
        if (wr == 1) PG8_BAR;
        PG8_WAIT_V(4); PG8_BAR;
        PG8_STAGE(PG8_SB(1, 0), cB + kstep, voffB); PG8_STAGE(PG8_SA(1, 0), cA + kstep, voffA); PG8_STAGE(PG8_SB(1, 1), cB + hstep + kstep, voffB);
        PG8_WAIT_V(6); PG8_BAR;
    }
    for (;;) {
        const bool has_next = S.next(ui + 1, nxt);
        const char* nA = has_next ? (const char*)g.A + (size_t)nxt.pm * tstep : cA; const char* nB = has_next ? (const char*)g.Bt + (size_t)nxt.pn * tstep : cB;
        for (int t = 0; t < nt; t += 2) {
            const bool last = (t == nt - 2);
            const char* a1 = cA + (size_t)(t + 1) * kstep;
            const char* a2 = last ? nA : cA + (size_t)(t + 2) * kstep; const char* b2 = last ? nB : cB + (size_t)(t + 2) * kstep;
            const char* a3 = a2 + kstep; const char* b3 = b2 + kstep;
            if (last && has_next) S.a_ready(nxt);
            if constexpr (SP2) {
            PG8_LDB(B0, 0, 0); PG8_LDB(B1, 0, 1); PG8_SCHED; PG8_LDA(At, 0, 0); PG8_STAGE(PG8_SA(1, 1), a1 + hstep, voffA);
            PG8_WAIT_V(8); PG8_WAIT_L(0); PG8_BAR; PG8_MMA(0, 0, At, B0); PG8_MMA(0, 1, At, B1); PG8_BAR; PG8_SCHED;
            PG8_LDA(At, 0, 1); PG8_STAGE(PG8_SB(0, 0), b2, voffB); PG8_STAGE(PG8_SB(0, 1), b2 + hstep, voffB); PG8_STAGE(PG8_SA(0, 0), a2, voffA);
            PG8_WAIT_V(8); PG8_WAIT_L(0); PG8_BAR; PG8_MMA(1, 0, At, B0); PG8_MMA(1, 1, At, B1); PG8_BAR; PG8_SCHED;
            PG8_LDB(B0, 1, 0); PG8_LDB(B1, 1, 1); PG8_SCHED; PG8_LDA(At, 1, 0); PG8_STAGE(PG8_SA(0, 1), a2 + hstep, voffA);
            PG8_WAIT_V(8); PG8_WAIT_L(0); PG8_BAR; PG8_MMA(0, 0, At, B0); PG8_MMA(0, 1, At, B1); PG8_BAR; PG8_SCHED;
            PG8_LDA(At, 1, 1); PG8_STAGE(PG8_SB(1, 0), b3, voffB); PG8_STAGE(PG8_SB(1, 1), b3 + hstep, voffB); PG8_STAGE(PG8_SA(1, 0), a3, voffA);
            PG8_WAIT_V(8); PG8_WAIT_L(0); PG8_BAR; PG8_MMA(1, 0, At, B0); PG8_MMA(1, 1, At, B1); PG8_BAR; PG8_SCHED;
            } else {
            PG8_LDB(B0, 0, 0); PG8_SCHED; PG8_LDA(At, 0, 0); PG8_STAGE(PG8_SA(1, 1), a1 + hstep, voffA);
            PG8_WAIT_L(8); PG8_BAR; PG8_WAIT_L(0); PG8_MMA(0, 0, At, B0); PG8_BAR; PG8_SCHED;
            PG8_LDB(B1, 0, 1); PG8_STAGE(PG8_SB(0, 0), b2, voffB);
            PG8_BAR; PG8_WAIT_L(0); PG8_MMA(0, 1, At, B1); PG8_BAR;
            PG8_LDA(At, 0, 1); PG8_STAGE(PG8_SA(0, 0), a2, voffA);
            PG8_BAR; PG8_WAIT_L(0); PG8_MMA(1, 0, At, B0); PG8_BAR; PG8_SCHED;
            PG8_STAGE(PG8_SB(0, 1), b2 + hstep, voffB);
            PG8_WAIT_V(6); PG8_BAR; PG8_MMA(1, 1, At, B1); PG8_BAR;
            PG8_LDB(B0, 1, 0); PG8_SCHED; PG8_LDA(At, 1, 0); PG8_STAGE(PG8_SA(0, 1), a2 + hstep, voffA);
            PG8_WAIT_L(8); PG8_BAR; PG8_WAIT_L(0); PG8_MMA(0, 0, At, B0); PG8_BAR; PG8_SCHED;
            PG8_LDB(B1, 1, 1); PG8_STAGE(PG8_SB(1, 0), b3, voffB);
            PG8_BAR; PG8_WAIT_L(0); PG8_MMA(0, 1, At, B1); PG8_BAR;
            PG8_LDA(At, 1, 1); PG8_STAGE(PG8_SA(1, 0), a3, voffA);
            PG8_BAR; PG8_WAIT_L(0); PG8_MMA(1, 0, At, B0); PG8_BAR; PG8_SCHED;
            PG8_STAGE(PG8_SB(1, 1), b3 + hstep, voffB);
            PG8_WAIT_V(6); PG8_BAR; PG8_MMA(1, 1, At, B1); PG8_BAR;
            }
        }
        if constexpr (ALIGN_EPI) { if (wr == 0) PG8_BAR; }
        if constexpr (!Epi::AFTER_DRAIN) { E(acc, cur, wr, wc, fr, fq); S.done(cur); }
        if (!has_next) break;
#pragma unroll
        for (int a = 0; a < 2; ++a)
#pragma unroll
            for (int b = 0; b < 2; ++b)
#pragma unroll
                for (int m = 0; m < 4; ++m)
#pragma unroll
                    for (int n = 0; n < 2; ++n) acc[a][b][m][n] = (f32x4){0.f, 0.f, 0.f, 0.f};
        cur = nxt; cA = nA; cB = nB; ++ui;
        if constexpr (ALIGN_EPI) { if (wr == 1) PG8_BAR; }
    }
    PG8_WAIT_V(0);
    if constexpr (!ALIGN_EPI) { if (wr == 0) PG8_BAR; }
    PG8_BAR;
    if constexpr (Epi::AFTER_DRAIN) { E.fused(acc, cur, wr, wc, fr, fq, lds, wid, lane); S.done(cur); }
#undef PG8_SA
#undef PG8_SB
#undef PG8_STAGE
#undef PG8_LDA
#undef PG8_LDB
#undef PG8_MMA
#undef PG8_WAIT_V
#undef PG8_WAIT_L
#undef PG8_BAR
#undef PG8_SCHED
}
}
#define LAS __attribute__((address_space(3)))
typedef unsigned short bf16;
typedef unsigned v4u __attribute__((ext_vector_type(4)));
typedef unsigned v2u __attribute__((ext_vector_type(2)));
typedef float f32x4 __attribute__((ext_vector_type(4)));
typedef short s16x8 __attribute__((ext_vector_type(8)));
typedef short s16x4 __attribute__((ext_vector_type(4)));

constexpr int NB = 8, SEQ = 2048, DM = 2048, NTOK = NB * SEQ, FF = 5632, NWAVES = 8;
constexpr int DOWN_N = 1088, DOWN_NP = 1280;
constexpr float EPS = 1e-6f;
constexpr float LOG2E = 1.4426950408889634f, LN2 = 0.6931471805599453f;
constexpr float QSCALE_MLA = 0.07216878364870322f * LOG2E;
constexpr float QSCALE_DIL = 0.08838834764831845f * LOG2E;
constexpr int LDS_BYTES = 147456;

constexpr size_t MiB = (size_t)1 << 20;
constexpr size_t WS_WQKV = 0, WS_WD = 0, WS_WUQ = 8 * MiB, WS_WUKV = 12 * MiB, WS_WO = 72 * MiB, WS_WGU = 80 * MiB, WS_WDN = 124 * MiB;
constexpr size_t WS_BAR = 146 * MiB;
constexpr int MISC_OFF = 131072 + 320, EX_OFF = 131072 + 1024;
constexpr size_t WS_SS = 279 * MiB;
constexpr size_t WS_MTAB = 277 * MiB;
constexpr size_t WS_H = 148 * MiB, WS_O = 212 * MiB, WS_LSE = 276 * MiB;
constexpr size_t WS_DOWN = 280 * MiB, WS_CQ = 320 * MiB, WS_CKV = 336 * MiB, WS_KROPE = 352 * MiB, WS_QRAW = 356 * MiB, WS_KVRAW = 452 * MiB;
constexpr size_t WS_COST = 280 * MiB, WS_SINT = 284 * MiB;
constexpr size_t WS_A = 356 * MiB, WS_QKVG = 356 * MiB, WS_END = 580 * MiB;

struct Params { const void* in[19]; float* out; unsigned char* ws; };

__device__ __forceinline__ unsigned f2bf(float f) { unsigned u = __builtin_bit_cast(unsigned, f); return (u + 0x7fffu + ((u >> 16) & 1u)) >> 16; }
__device__ __forceinline__ unsigned pk2(float lo, float hi) { unsigned r; asm("v_cvt_pk_bf16_f32 %0, %1, %2" : "=v"(r) : "v"(lo), "v"(hi)); return r; }
__device__ __forceinline__ float bf2f(unsigned u) { return __builtin_bit_cast(float, u << 16); }
__device__ __forceinline__ float shfl_xor_l(float v, int o) { int l = (int)__builtin_amdgcn_mbcnt_hi(~0u, __builtin_amdgcn_mbcnt_lo(~0u, 0u)); asm volatile("" : "+v"(l));
    return __builtin_bit_cast(float, __builtin_amdgcn_ds_bpermute((l ^ o) << 2, __builtin_bit_cast(int, v))); }
__device__ __forceinline__ float wave_sum(float v) {
#pragma unroll
    for (int o = 1; o < 64; o <<= 1) v += shfl_xor_l(v, o);
    return v;
}
#define LDS_WAIT() asm volatile("s_waitcnt lgkmcnt(0)" ::: "memory")
__device__ __forceinline__ void swap16(float& a, float& b) { asm volatile("s_nop 1\n\tv_permlane16_swap_b32 %0, %1" : "+v"(a), "+v"(b)); }
__device__ __forceinline__ void swap32(float& a, float& b) { asm volatile("s_nop 1\n\tv_permlane32_swap_b32 %0, %1" : "+v"(a), "+v"(b)); }
__device__ __forceinline__ float xmax4(float x) { float a = x, b = x; swap16(a, b); a = fmaxf(a, b); b = a; swap32(a, b); return fmaxf(a, b); }
__device__ __forceinline__ float xsum4(float x) { float a = x, b = x; swap16(a, b); a = a + b; b = a; swap32(a, b); return a + b; }

template <bool QKPERM, bool GAIN> __device__ __forceinline__ void tr_item(const float* W, int K, int N, bf16* WT, int k0, int n0, int dst_row0, LAS float* scr, int lane, int dbase, const float* kgain) {
    float wv[32];
#pragma unroll
    for (int i = 0; i < 32; ++i) { const int kk = 2 * i + (lane >> 5); wv[i] = W[(size_t)(k0 + kk) * N + n0 + (lane & 31)]; }
#pragma unroll
    for (int i = 0; i < 32; ++i) { const int kk = 2 * i + (lane >> 5); scr[kk * 33 + (lane & 31)] = GAIN ? wv[i] * kgain[k0 + kk] : wv[i]; }
    LDS_WAIT();
    const int c = lane & 7;
#pragma unroll
    for (int j = 0; j < 4; ++j) { const int n = (lane >> 3) + 8 * j; const LAS float* s = scr + (8 * c) * 33 + n;
        v4u o; o.x = pk2(s[0 * 33], s[1 * 33]); o.y = pk2(s[2 * 33], s[3 * 33]); o.z = pk2(s[4 * 33], s[5 * 33]); o.w = pk2(s[6 * 33], s[7 * 33]);
        int rown = dst_row0 + n; if (QKPERM) { const int d = dbase + n, r = d & 63; rown = dst_row0 + 32 * (r >> 4) + 8 * ((r >> 2) & 3) + 4 * (d >> 6) + (d & 3); }
        *(v4u*)(WT + (size_t)rown * K + k0 + 8 * c) = o; }
    LDS_WAIT();
}
template <int MAP, bool GAIN = false> __device__ __forceinline__ void conv_matrix(const float* W, int K, int N, bf16* WT, int which, LAS float* scr, int gw, int ngw, int lane, const float* kgain = nullptr, int gmask = 7) {
    const int nblk = N / 32, items = (K / 64) * nblk;
    for (int it = gw; it < items; it += ngw) {
        const int kb = it / nblk, nb = it - kb * nblk, n0 = 32 * nb;
        int dst = n0;
        if (MAP == 1) dst = 256 * (n0 >> 7) + 128 * which + (n0 & 127);
        if (MAP == 2) { const int w = n0 / 6144, rem = n0 - w * 6144, g = rem >> 11, hd = rem & 2047; dst = g * 6144 + w * 2048 + hd; if (!((gmask >> g) & 1)) continue;
            if (w < 2) { tr_item<true, GAIN>(W, K, N, WT, 64 * kb, n0, dst - (hd & 127), scr, lane, hd & 127, kgain); continue; } }
        tr_item<false, GAIN>(W, K, N, WT, 64 * kb, n0, dst, scr, lane, 0, kgain);
    }
}
__device__ __forceinline__ void norm_rows(const float* xin, const float* gain, bf16* H, int gw, int ngw, int lane) {
    for (int row = gw; row < NTOK; row += ngw) {
        const f32x4* xr = (const f32x4*)(xin + (size_t)row * DM) + lane;
        const f32x4* gr = (const f32x4*)gain + lane;
        f32x4 v[8]; float s = 0.f;
#pragma unroll
        for (int j = 0; j < 8; ++j) { v[j] = xr[64 * j]; s += (v[j].x * v[j].x + v[j].y * v[j].y) + (v[j].z * v[j].z + v[j].w * v[j].w); }
        const float rstd = rsqrtf(wave_sum(s) * (1.f / DM) + EPS);
        v2u* o8 = (v2u*)(H + (size_t)row * DM) + lane;
#pragma unroll
        for (int j = 0; j < 8; ++j) { const f32x4 g = gr[64 * j]; v2u w; w.x = pk2(v[j].x * rstd * g.x, v[j].y * rstd * g.y); w.y = pk2(v[j].z * rstd * g.z, v[j].w * rstd * g.w); o8[64 * j] = w; }
    }
}

struct AttnArgs {
    const bf16* q; long qp;
    const bf16* k; long kp;
    const bf16* k2; long k2p;
    const bf16* v; long vp;
    bf16* o; long op;
    float* lse; long lsep;
    const unsigned* qtab; const float* qgain;
    int cstart, nt, W, mode;
};
typedef short v4i16_t __attribute__((ext_vector_type(4)));
__device__ __forceinline__ s16x4 vtr(LAS const unsigned char* p) { return __builtin_bit_cast(s16x4, __builtin_amdgcn_ds_read_tr16_b64_v4i16((LAS v4i16_t*)p)); }

template <int DK, int RB, bool QPF, bool QN, class Sched>
__device__ __forceinline__ void attn_phase(LAS unsigned char* lds, const Sched& S, int tid, int wave, int lane) {
    constexpr int KS = DK / 32, KPB = DK * 2 + 16, NKL = (DK == 192) ? 3 : 2, VPB = 288, KOFF = 0, VOFF = 32768;
    const int fr = lane & 15, fq = lane >> 4;
    AttnArgs a, nx;
    bool has = S.get(0, a);
    if (!has) return;
    unsigned koff[NKL], voff[2], kdst[NKL], vdst[2];
#pragma unroll
    for (int p = 0; p < 2; ++p) { const int id = tid + 512 * p, row = id >> 4, ch = id & 15;
        koff[p] = (unsigned)(row * (int)a.kp + ch * 8) * 2u; kdst[p] = KOFF + row * KPB + ch * 16; voff[p] = (unsigned)(row * (int)a.vp + ch * 8) * 2u; vdst[p] = VOFF + row * VPB + ch * 16; }
    if (DK == 192) { const int row = tid >> 3, ch = tid & 7; koff[NKL - 1] = (unsigned)(row * (int)a.k2p + ch * 8) * 2u; kdst[NKL - 1] = KOFF + row * KPB + 256 + ch * 16; }
    const long kstep = 128 * a.kp, k2step = 128 * a.k2p, vstep = 128 * a.vp;
    const char* ktile; const char* k2tile = nullptr; const char* vtile;
    v4u kreg[NKL], vreg[2];
    s16x8 qn[QPF ? RB : 1][KS];
#define ATT_BASE(A) do { ktile = (const char*)((A).k + (long)(A).cstart * (A).kp); if (DK == 192) k2tile = (const char*)((A).k2 + (long)(A).cstart * (A).k2p); vtile = (const char*)((A).v + (long)(A).cstart * (A).vp); } while (0)
#define ATT_LOAD() do { \
        kreg[0] = *(const v4u*)(ktile + koff[0]); kreg[1] = *(const v4u*)(ktile + koff[1]); if (DK == 192) kreg[NKL - 1] = *(const v4u*)(k2tile + koff[NKL - 1]); \
        vreg[0] = *(const v4u*)(vtile + voff[0]); vreg[1] = *(const v4u*)(vtile + voff[1]); ktile += kstep; vtile += vstep; if (DK == 192) k2tile += k2step; } while (0)
#define ATT_QLOAD(DST, A) do { _Pragma("unroll") for (int rb_ = 0; rb_ < RB; ++rb_) { const bf16* qrow_ = (A).q + (long)(wave * 16 * RB + rb_ * 16 + fr) * (A).qp + fq * 8; \
        _Pragma("unroll") for (int ks_ = 0; ks_ < KS; ++ks_) DST[rb_][ks_] = *(const s16x8*)(qrow_ + ks_ * 32); } } while (0)
    if (QPF) ATT_QLOAD(qn, a);
    ATT_BASE(a); ATT_LOAD();
    const int w_lo = wave * 16 * RB, w_hi = w_lo + 16 * RB - 1;
    for (int ui = 0; has; ++ui) {
        const bool hasn = S.get(ui + 1, nx);
        s16x8 qf[RB][KS];
        if (QPF) {
#pragma unroll
            for (int rb = 0; rb < RB; ++rb)
#pragma unroll
                for (int ks = 0; ks < KS; ++ks) qf[rb][ks] = qn[rb][ks];
        } else ATT_QLOAD(qf, a);
        if (QN) {
#pragma unroll
            for (int rb = 0; rb < RB; ++rb) {
                const unsigned* tr = a.qtab + (size_t)(w_lo + rb * 16 + fr) * 32 + fq * 8;
                const v4u t0 = *(const v4u*)tr, t1 = *(const v4u*)(tr + 4);
                float x[KS][8]; float ssn = 0.f, ssr = 0.f;
#pragma unroll
                for (int ks = 0; ks < KS; ++ks)
#pragma unroll
                    for (int e = 0; e < 8; ++e) { x[ks][e] = bf2f((unsigned short)qf[rb][ks][e]); if (ks < 4) ssn += x[ks][e] * x[ks][e]; else ssr += x[ks][e] * x[ks][e]; }
                ssn = xsum4(ssn); ssr = xsum4(ssr);
                const float rn = rsqrtf(ssn * (1.f / 128) + EPS) * QSCALE_MLA, rr = rsqrtf(ssr * (1.f / 64) + EPS);
#pragma unroll
                for (int ks = 0; ks < 4; ++ks) { const f32x4 g0 = *(const f32x4*)(a.qgain + ks * 32 + fq * 8), g1 = *(const f32x4*)(a.qgain + ks * 32 + fq * 8 + 4);
                    v4u w; w.x = pk2(x[ks][0] * rn * g0.x, x[ks][1] * rn * g0.y); w.y = pk2(x[ks][2] * rn * g0.z, x[ks][3] * rn * g0.w); w.z = pk2(x[ks][4] * rn * g1.x, x[ks][5] * rn * g1.y); w.w = pk2(x[ks][6] * rn * g1.z, x[ks][7] * rn * g1.w);
                    qf[rb][ks] = __builtin_bit_cast(s16x8, w); }
                { const f32x4 ga0 = *(const f32x4*)(a.qgain + 128 + fq * 8), ga1 = *(const f32x4*)(a.qgain + 132 + fq * 8), gb0 = *(const f32x4*)(a.qgain + 160 + fq * 8), gb1 = *(const f32x4*)(a.qgain + 164 + fq * 8);
                  const float gA[8] = {ga0.x, ga0.y, ga0.z, ga0.w, ga1.x, ga1.y, ga1.z, ga1.w}, gB[8] = {gb0.x, gb0.y, gb0.z, gb0.w, gb1.x, gb1.y, gb1.z, gb1.w};
                  const unsigned tw[8] = {t0.x, t0.y, t0.z, t0.w, t1.x, t1.y, t1.z, t1.w};
                  float o1[8], o2[8];
#pragma unroll
                  for (int e = 0; e < 8; ++e) { const float cs = (float)((int)(tw[e] << 16) >> 16) * (1.f / 32767.f), sn = (float)((int)tw[e] >> 16) * (1.f / 32767.f);
                      const float y1 = x[4][e] * rr * gA[e], y2 = x[5][e] * rr * gB[e]; o1[e] = (y1 * cs - y2 * sn) * QSCALE_MLA; o2[e] = (y2 * cs + y1 * sn) * QSCALE_MLA; }
                  v4u w1, w2; w1.x = pk2(o1[0], o1[1]); w1.y = pk2(o1[2], o1[3]); w1.z = pk2(o1[4], o1[5]); w1.w = pk2(o1[6], o1[7]); w2.x = pk2(o2[0], o2[1]); w2.y = pk2(o2[2], o2[3]); w2.z = pk2(o2[4], o2[5]); w2.w = pk2(o2[6], o2[7]);
                  qf[rb][4] = __builtin_bit_cast(s16x8, w1); qf[rb][5] = __builtin_bit_cast(s16x8, w2); }
            }
        }
        v2u oldo[RB][8]; float oldl[RB];
        if (a.mode == 2) {
#pragma unroll
            for (int rb = 0; rb < RB; ++rb) { const int iq = w_lo + rb * 16 + fr; const bf16* orow = a.o + (long)iq * a.op + fq * 4; oldl[rb] = a.lse[(long)iq * a.lsep];
#pragma unroll
                for (int db = 0; db < 8; ++db) oldo[rb][db] = *(const v2u*)(orow + db * 16); }
        }
        f32x4 o[RB][8];
        float m[RB], l[RB];
#pragma unroll
        for (int rb = 0; rb < RB; ++rb) { m[rb] = -1e30f; l[rb] = 0.f;
#pragma unroll
            for (int db = 0; db < 8; ++db) o[rb][db] = (f32x4){0.f, 0.f, 0.f, 0.f}; }
        for (int t = 0; t < a.nt; ++t) {
            __syncthreads();
#pragma unroll
            for (int p = 0; p < NKL; ++p) *(LAS v4u*)(lds + kdst[p]) = kreg[p];
#pragma unroll
            for (int p = 0; p < 2; ++p) *(LAS v4u*)(lds + vdst[p]) = vreg[p];
            __syncthreads();
            if (t + 1 < a.nt) ATT_LOAD();
            else if (hasn) { if (QPF) ATT_QLOAD(qn, nx); ATT_BASE(nx); ATT_LOAD(); }
            const int ct = a.cstart + 64 * t;
            const bool needed = (ct <= w_hi) && (ct + 63 >= w_lo - a.W);
            if (needed) {
                f32x4 s[RB][4];
#pragma unroll
                for (int kb = 0; kb < 4; ++kb) {
#pragma unroll
                    for (int rb = 0; rb < RB; ++rb) s[rb][kb] = (f32x4){0.f, 0.f, 0.f, 0.f};
                    const int row = kb * 16 + fr;
                    LAS const unsigned char* kp = lds + KOFF + row * KPB + fq * 16;
#pragma unroll
                    for (int ks = 0; ks < KS; ++ks) { const s16x8 kf = *(LAS const s16x8*)(kp + ks * 64);
#pragma unroll
                        for (int rb = 0; rb < RB; ++rb) s[rb][kb] = __builtin_amdgcn_mfma_f32_16x16x32_bf16(kf, qf[rb][ks], s[rb][kb], 0, 0, 0); }
                }
                s16x8 pf[RB][2];
#pragma unroll
                for (int rb = 0; rb < RB; ++rb) {
                    const int i_lo = w_lo + rb * 16, i_hi = i_lo + 15, iq = i_lo + fr;
                    const bool full = (ct + 63 <= i_lo) && (ct >= i_hi - a.W);
                    if (!full) {
#pragma unroll
                        for (int kb = 0; kb < 4; ++kb)
#pragma unroll
                            for (int j = 0; j < 4; ++j) { const int c = ct + kb * 16 + fq * 4 + j; const bool ok = (c <= iq) && (c >= iq - a.W); s[rb][kb][j] = ok ? s[rb][kb][j] : -1e30f; }
                    }
                    float mx = fmaxf(fmaxf(fmaxf(s[rb][0][0], s[rb][0][1]), fmaxf(s[rb][0][2], s[rb][0][3])), fmaxf(fmaxf(s[rb][1][0], s[rb][1][1]), fmaxf(s[rb][1][2], s[rb][1][3])));
                    mx = fmaxf(mx, fmaxf(fmaxf(fmaxf(s[rb][2][0], s[rb][2][1]), fmaxf(s[rb][2][2], s[rb][2][3])), fmaxf(fmaxf(s[rb][3][0], s[rb][3][1]), fmaxf(s[rb][3][2], s[rb][3][3]))));
                    mx = xmax4(mx);
                    const float mn = fmaxf(m[rb], mx), alpha = __builtin_amdgcn_exp2f(m[rb] - mn);
                    m[rb] = mn;
                    float ps = 0.f;
#pragma unroll
                    for (int kb = 0; kb < 4; ++kb)
#pragma unroll
                        for (int j = 0; j < 4; ++j) { s[rb][kb][j] = __builtin_amdgcn_exp2f(s[rb][kb][j] - mn); ps += s[rb][kb][j]; }
                    l[rb] = l[rb] * alpha + ps;
                    if (__builtin_amdgcn_ballot_w64(alpha != 1.f) != 0ull) {
#pragma unroll
                        for (int db = 0; db < 8; ++db) o[rb][db] = o[rb][db] * alpha; }
#pragma unroll
                    for (int h2 = 0; h2 < 2; ++h2) { v4u w; w.x = pk2(s[rb][2 * h2][0], s[rb][2 * h2][1]); w.y = pk2(s[rb][2 * h2][2], s[rb][2 * h2][3]); w.z = pk2(s[rb][2 * h2 + 1][0], s[rb][2 * h2 + 1][1]); w.w = pk2(s[rb][2 * h2 + 1][2], s[rb][2 * h2 + 1][3]);
                        pf[rb][h2] = __builtin_bit_cast(s16x8, w); }
                }
#pragma unroll
                for (int db = 0; db < 8; ++db)
#pragma unroll
                    for (int h2 = 0; h2 < 2; ++h2) {
                        LAS const unsigned char* vp = lds + VOFF + (h2 * 32 + fq * 4 + (fr >> 2)) * VPB + (db * 16 + (fr & 3) * 4) * 2;
                        const s16x4 lo = vtr(vp), hi = vtr(vp + 16 * VPB);
                        const s16x8 vf = {lo[0], lo[1], lo[2], lo[3], hi[0], hi[1], hi[2], hi[3]};
#pragma unroll
                        for (int rb = 0; rb < RB; ++rb) o[rb][db] = __builtin_amdgcn_mfma_f32_16x16x32_bf16(vf, pf[rb][h2], o[rb][db], 0, 0, 0);
                    }
            }
        }
#pragma unroll
        for (int rb = 0; rb < RB; ++rb) {
            const int iq = w_lo + rb * 16 + fr;
            const float lt = xsum4(l[rb]);
            const float inv = 1.f / lt;
            bf16* orow = a.o + (long)iq * a.op + fq * 4;
            if (a.mode == 0) {
#pragma unroll
                for (int db = 0; db < 8; ++db) { v2u w; w.x = pk2(o[rb][db][0] * inv, o[rb][db][1] * inv); w.y = pk2(o[rb][db][2] * inv, o[rb][db][3] * inv); *(v2u*)(orow + db * 16) = w; }
            } else {
                float* lp = a.lse + (long)iq * a.lsep;
                float lse = m[rb] * LN2 + __logf(lt);
                float wn = inv, wo = 0.f;
                if (a.mode == 2) { const float lo = oldl[rb], mm = fmaxf(lo, lse), eo = __expf(lo - mm), en = __expf(lse - mm), den = eo + en; wo = eo / den; wn = en / den * inv; lse = mm + __logf(den); }
#pragma unroll
                for (int db = 0; db < 8; ++db) {
                    float r0 = o[rb][db][0] * wn, r1 = o[rb][db][1] * wn, r2 = o[rb][db][2] * wn, r3 = o[rb][db][3] * wn;
                    if (a.mode == 2) { const v2u old = oldo[rb][db]; r0 += wo * bf2f(old.x & 0xffffu); r1 += wo * bf2f(old.x >> 16); r2 += wo * bf2f(old.y & 0xffffu); r3 += wo * bf2f(old.y >> 16); }
                    v2u w; w.x = pk2(r0, r1); w.y = pk2(r2, r3); *(v2u*)(orow + db * 16) = w;
                }
                if (fq == 0) *lp = lse;
            }
        }
        a = nx; has = hasn;
    }
#undef ATT_LOAD
#undef ATT_BASE
#undef ATT_QLOAD
}
#define XB_TMO      128
#define XB_XCNT(j)  (256  + 64 * (j))
#define XB_XSUB(j)  (1280 + 64 * (j))
#define XB_XGEN(j)  (2304 + 64 * (j))
#define XB_TOP      3328
#define XB_TOPGEN   3392
#define XCD_BAR_WORDS 3456
#define XB_SPIN_CAP (1u << 18)

__device__ __forceinline__ unsigned xb_ld(unsigned* p)              { return __hip_atomic_load(p, __ATOMIC_RELAXED, __HIP_MEMORY_SCOPE_AGENT); }
__device__ __forceinline__ unsigned xb_add(unsigned* p, unsigned v) { return __hip_atomic_fetch_add(p, v, __ATOMIC_RELAXED, __HIP_MEMORY_SCOPE_AGENT); }
__device__ __forceinline__ unsigned xb_xcc_id() { return (unsigned)__builtin_amdgcn_s_getreg((3 << 11) | 20) & 0xFu; }
#define XB_SPIN(cond, bar) do { unsigned _sp = 0; while (cond) { __builtin_amdgcn_s_sleep(1); \
    if ((++_sp & 255u) == 0u) { if (xb_ld(&(bar)[XB_TMO])) break; if (_sp > XB_SPIN_CAP) { atomicAdd(&(bar)[XB_TMO], 1u); break; } } } } while (0)

struct XcdBarrier {
    unsigned* bar; unsigned x;
    volatile LAS unsigned* st;
};

__device__ __forceinline__ XcdBarrier xcd_barrier_post(unsigned* bar, volatile LAS unsigned* st) {
    XcdBarrier b; b.bar = bar; b.x = xb_xcc_id(); b.st = st;
    if (threadIdx.x == 0) (void)xb_add(&bar[XB_XCNT(b.x)], 1u);
    return b;
}
__device__ __forceinline__ void xcd_barrier_complete(unsigned* bar, unsigned x, unsigned& nloc, unsigned& nx) {
    const unsigned G = gridDim.x * gridDim.y * gridDim.z;
    unsigned sum, cnt, mine, sp = 0u;
    for (;;) {
        sum = 0u; cnt = 0u; mine = 0u;
#pragma unroll
        for (unsigned j = 0; j < 16; ++j) { const unsigned c = xb_ld(&bar[XB_XCNT(j)]); sum += c; cnt += (c > 0u) ? 1u : 0u; mine = (j == x) ? c : mine; }
        if (sum == G) break;
        __builtin_amdgcn_s_sleep(1);
        if ((++sp & 255u) == 0u) { if (xb_ld(&bar[XB_TMO])) break; if (sp > XB_SPIN_CAP) { atomicAdd(&bar[XB_TMO], 1u); break; } }
    }
    nloc = mine > 0u ? mine : 1u; nx = cnt > 0u ? cnt : 1u;
}

__device__ __forceinline__ void xcd_barrier(const XcdBarrier& b) {
    asm volatile("s_waitcnt vmcnt(0)" ::: "memory");
    __syncthreads();
    if (threadIdx.x == 0) {
        unsigned* bar = b.bar;
        __builtin_amdgcn_s_waitcnt(0);
        unsigned nloc = b.st[0], nx = b.st[1];
        if (nloc == 0u) { xcd_barrier_complete(bar, b.x, nloc, nx); b.st[0] = nloc; b.st[1] = nx; }
        const unsigned old = xb_add(&bar[XB_XSUB(b.x)], 1u);
        const unsigned gen = old / nloc;
        if (old + 1u == (gen + 1u) * nloc) {
            __builtin_amdgcn_fence(__ATOMIC_RELEASE, "agent");
            asm volatile("s_waitcnt vmcnt(0)" ::: "memory");
            const unsigned og = xb_add(&bar[XB_TOP], 1u);
            const unsigned tg = og / nx;
            if (og + 1u == (tg + 1u) * nx) xb_add(&bar[XB_TOPGEN], 1u);
            else XB_SPIN(xb_ld(&bar[XB_TOPGEN]) == tg, bar);
            __builtin_amdgcn_fence(__ATOMIC_ACQUIRE, "agent");
            xb_add(&bar[XB_XGEN(b.x)], 1u);
            asm volatile("s_waitcnt vmcnt(0)" ::: "memory");
        } else {
            XB_SPIN(xb_ld(&bar[XB_XGEN(b.x)]) == gen, bar);
            __builtin_amdgcn_fence(__ATOMIC_ACQUIRE, "agent");
            asm volatile("s_waitcnt vmcnt(0)" ::: "memory");
        }
    }
    __syncthreads();
}
template <class Epi, bool ALIGN = true, int WGMV = 4> __device__ __forceinline__ void run_gemm(LAS unsigned char* lds, const bf16* A, const bf16* Bt, int M, int N, int K, const Epi& E) {
    pg8::Gemm g{A, Bt, M, N, K}; pg8::StaticOrder S; S.init(M, N, (int)gridDim.x, (int)blockIdx.x, WGMV);
    pg8::gemm_phase<Epi, pg8::StaticOrder, ALIGN, true>(lds, g, S, E);
}


#define GAS __attribute__((address_space(1)))
__device__ __forceinline__ void* karg(int i) { typedef void* const volatile __attribute__((address_space(4))) * kargp_t; kargp_t ka = (kargp_t)__builtin_amdgcn_kernarg_segment_ptr(); void* q = ka[i]; return (void*)(GAS void*)q; }
#define INF(i) ((const float*)karg(i))
#define WSB(off) ((bf16*)((unsigned char*)karg(20) + (off)))
#define P_x INF(0)
#define P_positions ((const int*)karg(1))
#define P_mixer_norm INF(2)
#define P_ffn_norm INF(3)
#define P_mla_w_down INF(4)
#define P_mla_q_norm INF(5)
#define P_mla_kv_norm INF(6)
#define P_mla_w_uq INF(7)
#define P_mla_w_ukv INF(8)
#define P_mla_q_gain INF(9)
#define P_mla_k_gain INF(10)
#define P_mla_w_o INF(11)
#define P_dil_w_qkv INF(12)
#define P_dil_q_gain INF(13)
#define P_dil_k_gain INF(14)
#define P_dil_w_o INF(15)
#define P_ffn_w_gate INF(16)
#define P_ffn_w_up INF(17)
#define P_ffn_w_down INF(18)
#define P_out ((float*)karg(19))
#define P_Wqkv_t WSB(WS_WQKV)
#define P_Wd_t WSB(WS_WD)
#define P_Wuq_t WSB(WS_WUQ)
#define P_Wukv_t WSB(WS_WUKV)
#define P_Wo_t WSB(WS_WO)
#define P_Wgu_t WSB(WS_WGU)
#define P_Wdn_t WSB(WS_WDN)
#define P_H WSB(WS_H)
#define P_O WSB(WS_O)
#define P_LSE ((float*)WSB(WS_LSE))
#define P_DOWN WSB(WS_DOWN)
#define P_CQ WSB(WS_CQ)
#define P_CKV WSB(WS_CKV)
#define P_KROPE WSB(WS_KROPE)
#define P_QRAW WSB(WS_QRAW)
#define P_KVRAW WSB(WS_KVRAW)
#define P_ACT WSB(WS_A)
#define P_QKVG WSB(WS_QKVG)
__global__ void __launch_bounds__(NWAVES * 64, 2) fwd_kernel(Params p) {
    extern __shared__ __attribute__((aligned(16))) unsigned char lds_raw[];
    LAS unsigned char* lds = (LAS unsigned char*)lds_raw;
#define PHASE_IDS int tid_ = threadIdx.x; asm volatile("" : "+v"(tid_)); const int tid = tid_, lane = tid & 63, wave = __builtin_amdgcn_readfirstlane(tid >> 6); \
    const int G = gridDim.x, gw = blockIdx.x * NWAVES + wave, ngw = G * NWAVES; LAS float* scr = (LAS float*)(lds + wave * 16384); (void)scr; (void)gw; (void)ngw; (void)lane; (void)G;

    if (threadIdx.x < 32) ((LAS unsigned*)(lds + MISC_OFF))[threadIdx.x] = 0u;
    __syncthreads();
    XcdBarrier xbar = xcd_barrier_post((unsigned*)((unsigned char*)karg(20) + WS_BAR), (volatile LAS unsigned*)(lds + MISC_OFF) + 8);
#define GRID_SYNC() do { XcdBarrier b_; b_.bar = (unsigned*)((unsigned char*)karg(20) + WS_BAR); b_.x = xb_xcc_id(); b_.st = (volatile LAS unsigned*)(lds + MISC_OFF) + 8; xcd_barrier(b_); } while (0)
    (void)xbar;
    for (int layer = 0; layer < 2; ++layer) {
        { PHASE_IDS
        if (layer == 0) norm_rows(P_x, P_mixer_norm, P_H, gw, ngw, lane);
        if (layer == 0) {
            bf16* const wd_t = P_Wd_t;
            { float* const ssz = (float*)WSB(WS_SS); for (int i = blockIdx.x * 512 + tid; i < 2 * NTOK; i += G * 512) { float zz = 0.f; asm volatile("" : "+v"(zz)); ssz[i] = zz; } }
            { unsigned* const tm = (unsigned*)WSB(WS_MTAB); const int* const pos = P_positions; const float ifr = powf(10000.f, -2.f * (float)(lane & 31) / 64.f);
              for (int t2 = gw; t2 < NTOK / 2; t2 += ngw) { const int t = 2 * t2 + (lane >> 5); const float ang = (float)pos[t] * ifr; const int ci = (int)rintf(cosf(ang) * 32767.f), si = (int)rintf(sinf(ang) * 32767.f);
                  tm[(size_t)t * 32 + (lane & 31)] = ((unsigned)ci & 0xffffu) | ((unsigned)si << 16); } }
            conv_matrix<0>(P_mla_w_down, DM, DOWN_N, wd_t, 0, scr, gw, ngw, lane);
            for (int i = blockIdx.x * 512 + tid; i < (DOWN_NP - DOWN_N) * DM / 8; i += G * 512) { unsigned zz = 0u; asm volatile("" : "+v"(zz)); ((v4u*)(wd_t + (size_t)DOWN_N * DM))[i] = (v4u){zz, zz, zz, zz}; }
            conv_matrix<0>(P_mla_w_uq, 512, 3072, P_Wuq_t, 0, scr, gw, ngw, lane);
            conv_matrix<0>(P_mla_w_ukv, 512, 4096, P_Wukv_t, 0, scr, gw, ngw, lane);
        } else {
            conv_matrix<2>(P_dil_w_qkv, DM, 18432, P_Wqkv_t, 0, scr, gw, ngw, lane, nullptr, 1);
            { unsigned* const tb = (unsigned*)WSB(WS_COST); const int* const pos = P_positions; const float ifr = powf(10000.f, -2.f * (float)lane / 128.f);
              for (int t = gw; t < NTOK; t += ngw) { const float ang = (float)pos[t] * ifr; const int ci = (int)rintf(cosf(ang) * 32767.f), si = (int)rintf(sinf(ang) * 32767.f);
                  tb[(size_t)t * 64 + lane] = ((unsigned)ci & 0xffffu) | ((unsigned)si << 16); } }
            conv_matrix<0>(P_dil_w_o, DM, DM, P_Wo_t, 0, scr, gw, ngw, lane);
        }
        if (layer == 1) {
        conv_matrix<1, true>(P_ffn_w_gate + (size_t)DM * FF, DM, FF, P_Wgu_t, 0, scr, gw, ngw, lane, P_ffn_norm + DM);
        conv_matrix<1, true>(P_ffn_w_up + (size_t)DM * FF, DM, FF, P_Wgu_t, 1, scr, gw, ngw, lane, P_ffn_norm + DM);
        conv_matrix<0>(P_ffn_w_down + (size_t)DM * FF, FF, DM, P_Wdn_t, 0, scr, gw, ngw, lane);
        norm_rows(P_out, P_mixer_norm + DM, P_H, gw, ngw, lane);
        }
        }
        if (gridDim.x == 0x7fffffffu) cg::this_grid().sync();
        GRID_SYNC();

        if (layer == 0) {
            { pg8::EpiStoreBf16 E{P_DOWN, DOWN_NP}; run_gemm(lds, P_H, P_Wd_t, NTOK, DOWN_NP, DM, E); }
            { PHASE_IDS
              const bool shadow = (G == 256);
              if (!shadow || blockIdx.x >= 64) {
                  const int gw2 = shadow ? ((int)blockIdx.x - 64) * NWAVES + wave : gw, ngw2 = shadow ? 192 * NWAVES : ngw;
                  conv_matrix<0>(P_mla_w_o, DM, DM, P_Wo_t, 0, scr, gw2, ngw2, lane);
                  conv_matrix<1, true>(P_ffn_w_gate, DM, FF, P_Wgu_t, 0, scr, gw2, ngw2, lane, P_ffn_norm);
                  conv_matrix<1, true>(P_ffn_w_up, DM, FF, P_Wgu_t, 1, scr, gw2, ngw2, lane, P_ffn_norm);
                  conv_matrix<0>(P_ffn_w_down, FF, DM, P_Wdn_t, 0, scr, gw2, ngw2, lane);
                  conv_matrix<2>(P_dil_w_qkv, DM, 18432, P_Wqkv_t, 0, scr, gw2, ngw2, lane, nullptr, 6);
              } }
            GRID_SYNC();
            { PHASE_IDS const bf16* const L_DOWN = P_DOWN; bf16* const L_CQ = P_CQ; bf16* const L_CKV = P_CKV; bf16* const L_KROPE = P_KROPE; const float* const L_mla_q_norm = P_mla_q_norm; const float* const L_mla_kv_norm = P_mla_kv_norm; const float* const L_mla_k_gain = P_mla_k_gain; const int* const L_positions = P_positions;
            const f32x4 ga0 = *(const f32x4*)(L_mla_q_norm + lane * 8), ga1 = *(const f32x4*)(L_mla_q_norm + lane * 8 + 4);
            const f32x4 gb0 = *(const f32x4*)(L_mla_kv_norm + lane * 8), gb1 = *(const f32x4*)(L_mla_kv_norm + lane * 8 + 4);
            const float gkr = L_mla_k_gain[128 + lane];
            const unsigned* const mtab = (const unsigned*)WSB(WS_MTAB);
            for (int t0 = gw; t0 < NTOK; t0 += 2 * ngw) {
                const int t1 = (t0 + ngw < NTOK) ? t0 + ngw : t0;
                s16x8 a8[2], b8[2]; float xr[2]; unsigned tw[2];
#pragma unroll
                for (int q = 0; q < 2; ++q) { const int t = q ? t1 : t0; const bf16* dr = L_DOWN + (size_t)t * DOWN_NP;
                    a8[q] = *(const s16x8*)(dr + lane * 8); b8[q] = *(const s16x8*)(dr + 512 + lane * 8); xr[q] = bf2f(dr[1024 + lane]); tw[q] = mtab[(size_t)t * 32 + (lane & 31)]; }
                float sa[2], sb[2], sr[2];
#pragma unroll
                for (int q = 0; q < 2; ++q) { sa[q] = 0.f; sb[q] = 0.f; sr[q] = xr[q] * xr[q];
#pragma unroll
                    for (int j = 0; j < 8; ++j) { const float fa = bf2f((unsigned short)a8[q][j]), fb = bf2f((unsigned short)b8[q][j]); sa[q] += fa * fa; sb[q] += fb * fb; } }
#pragma unroll
                for (int o = 1; o < 64; o <<= 1) {
#pragma unroll
                    for (int q = 0; q < 2; ++q) { sa[q] += shfl_xor_l(sa[q], o); sb[q] += shfl_xor_l(sb[q], o); sr[q] += shfl_xor_l(sr[q], o); } }
#pragma unroll
                for (int q = 0; q < 2; ++q) { const int t = q ? t1 : t0;
                    if (q == 1 && t1 == t0) break;
                    const float ra = rsqrtf(sa[q] * (1.f / 512) + EPS), rb = rsqrtf(sb[q] * (1.f / 512) + EPS), rr = rsqrtf(sr[q] * (1.f / 64) + EPS);
                    float fa[8], fb[8];
#pragma unroll
                    for (int j = 0; j < 8; ++j) { fa[j] = bf2f((unsigned short)a8[q][j]) * ra; fb[j] = bf2f((unsigned short)b8[q][j]) * rb; }
                    v4u wa, wb;
                    wa.x = pk2(fa[0] * ga0.x, fa[1] * ga0.y); wa.y = pk2(fa[2] * ga0.z, fa[3] * ga0.w); wa.z = pk2(fa[4] * ga1.x, fa[5] * ga1.y); wa.w = pk2(fa[6] * ga1.z, fa[7] * ga1.w);
                    wb.x = pk2(fb[0] * gb0.x, fb[1] * gb0.y); wb.y = pk2(fb[2] * gb0.z, fb[3] * gb0.w); wb.z = pk2(fb[4] * gb1.x, fb[5] * gb1.y); wb.w = pk2(fb[6] * gb1.z, fb[7] * gb1.w);
                    *(v4u*)(L_CQ + (size_t)t * 512 + lane * 8) = wa; *(v4u*)(L_CKV + (size_t)t * 512 + lane * 8) = wb;
                    const float y = xr[q] * rr * gkr, pr = shfl_xor_l(y, 32);
                    const float cs = (float)((int)(tw[q] << 16) >> 16) * (1.f / 32767.f), sn = (float)((int)tw[q] >> 16) * (1.f / 32767.f);
                    L_KROPE[(size_t)t * 64 + lane] = (bf16)f2bf(lane < 32 ? y * cs - pr * sn : y * cs + pr * sn);
                }
            } }
            GRID_SYNC();
            { pg8::EpiStoreBf16 E{P_QRAW, 3072}; run_gemm(lds, P_CQ, P_Wuq_t, NTOK, 3072, 512, E); }
            { pg8::EpiKVNorm E{P_KVRAW, 4096, P_mla_k_gain, (unsigned)(__SIZE_TYPE__)(lds + EX_OFF)}; run_gemm(lds, P_CKV, P_Wukv_t, NTOK, 4096, 512, E); }
            GRID_SYNC();
            { PHASE_IDS const bf16* const L_QRAW = P_QRAW; const bf16* const L_KVRAW = P_KVRAW; const bf16* const L_KROPE = P_KROPE; bf16* const L_O = P_O;
            struct MlaSched { const bf16* QR; const bf16* KV; const bf16* KR; bf16* OO; int c; const unsigned* TB; const float* QG;
                __device__ __forceinline__ bool get(int it, AttnArgs& a) const {
                    if (it >= 4 || c >= 256) return false;
                    const int bh = c & 127, half = (c >> 7) & 1, b = bh >> 4, h = bh & 15;
                    const int qb = half ? (it == 0 ? 6 : it == 1 ? 5 : it == 2 ? 2 : 1) : (it == 0 ? 7 : it == 1 ? 4 : it == 2 ? 3 : 0), q0 = qb * 256; const size_t tok0 = (size_t)b * SEQ + q0;
                    a.q = QR + tok0 * 3072 + h * 192; a.qp = 3072; a.k = KV + tok0 * 4096 + h * 256; a.kp = 4096; a.k2 = KR + tok0 * 64; a.k2p = 64;
                    a.v = KV + tok0 * 4096 + h * 256 + 128; a.vp = 4096; a.o = OO + tok0 * DM + h * 128; a.op = DM; a.lse = nullptr; a.lsep = 0;
                    a.cstart = -q0; a.nt = (q0 + 256) / 64; a.W = 1 << 24; a.mode = 0; a.qtab = TB + tok0 * 32; a.qgain = QG; return true; } };
            const MlaSched S{L_QRAW, L_KVRAW, L_KROPE, L_O, (int)blockIdx.x, (const unsigned*)WSB(WS_MTAB), P_mla_q_gain};
            attn_phase<192, 2, false, true, MlaSched>(lds, S, tid, wave, lane); }
            __syncthreads();
            GRID_SYNC();
        } else {
            for (int g = 0; g < 3; ++g) {
                { pg8::EpiQKRope E{P_QKVG, 6144, (const unsigned*)WSB(WS_COST), P_dil_q_gain + g * 128, P_dil_k_gain + g * 128, QSCALE_DIL, (unsigned)(__SIZE_TYPE__)(lds + EX_OFF)}; run_gemm(lds, P_H, P_Wqkv_t + (size_t)g * 6144 * DM, NTOK, 6144, DM, E); }
                GRID_SYNC();
                { PHASE_IDS const bf16* const L_QKVG = P_QKVG; bf16* const L_O = P_O; float* const L_LSE = P_LSE; const float* const L_COST = (const float*)WSB(WS_COST); const float* const L_SINT = (const float*)WSB(WS_SINT); const float* const L_dil_q_gain = P_dil_q_gain; const float* const L_dil_k_gain = P_dil_k_gain;
                struct DilSched { const bf16* QKV; bf16* OO; float* LS; int c, G, dl, nbk, mode;
                    __device__ __forceinline__ bool get(int i, AttnArgs& a) const {
                        const int u = c + i * G; if (u >= 2048) return false;
                        const int bh = u & 127, sub = u >> 7, b = bh >> 4, h = bh & 15, r = sub / nbk, blk = sub - r * nbk, i0 = blk * 128; const size_t tok0 = (size_t)b * SEQ + r + (size_t)dl * i0;
                        a.q = QKV + tok0 * 6144 + h * 128; a.qp = (long)dl * 6144; a.k = a.q + 2048; a.kp = a.qp; a.k2 = nullptr; a.k2p = 0; a.v = a.q + 4096; a.vp = a.qp;
                        a.o = OO + tok0 * DM + h * 128; a.op = (long)dl * DM; a.lse = LS + tok0 * 16 + h; a.lsep = (long)dl * 16;
                        a.cstart = blk == 0 ? 0 : -128; a.nt = blk == 0 ? 2 : 4; a.W = 128; a.mode = mode; a.qtab = nullptr; a.qgain = nullptr; return true; } };
                const int dl = (g == 0) ? 1 : (g == 1 ? 4 : 16);
                const DilSched S{L_QKVG, L_O, L_LSE, (int)blockIdx.x, G, dl, 16 / dl, g == 0 ? 1 : 2};
                attn_phase<128, 1, true, false, DilSched>(lds, S, tid, wave, lane); }
                __syncthreads();
                GRID_SYNC();
            }
        }
        { pg8::EpiResF32Stat E{layer == 0 ? P_x : P_out, P_out, DM, P_H, (float*)WSB(WS_SS) + layer * NTOK}; run_gemm(lds, P_O, P_Wo_t, NTOK, DM, DM, E); }
        GRID_SYNC();
        { pg8::EpiSwiGLU E{P_ACT, FF, (const float*)WSB(WS_SS) + layer * NTOK}; run_gemm(lds, P_H, P_Wgu_t, NTOK, 2 * FF, DM, E); }
        GRID_SYNC();
        { pg8::EpiResF32 E{P_out, P_out, DM}; run_gemm<pg8::EpiResF32, true, 2>(lds, P_ACT, P_Wdn_t, NTOK, DM, FF, E); }
        GRID_SYNC();
    }
}

#undef P_x
#undef P_positions
#undef P_mixer_norm
#undef P_ffn_norm
#undef P_mla_w_down
#undef P_mla_q_norm
#undef P_mla_kv_norm
#undef P_mla_w_uq
#undef P_mla_w_ukv
#undef P_mla_q_gain
#undef P_mla_k_gain
#undef P_mla_w_o
#undef P_dil_w_qkv
#undef P_dil_q_gain
#undef P_dil_k_gain
#undef P_dil_w_o
#undef P_ffn_w_gate
#undef P_ffn_w_up
#undef P_ffn_w_down
#undef P_out
#undef P_Wqkv_t
#undef P_Wd_t
#undef P_Wuq_t
#undef P_Wukv_t
#undef P_Wo_t
#undef P_Wgu_t
#undef P_Wdn_t
#undef P_H
#undef P_O
#undef P_LSE
#undef P_DOWN
#undef P_CQ
#undef P_CKV
#undef P_KROPE
#undef P_QRAW
#undef P_KVRAW
#undef P_ACT
#undef P_QKVG
extern "C" void kernel_launch(void* const* d_in, const int* in_sizes, int n_in, void* d_out, int out_size, void* d_ws, size_t ws_size, hipStream_t stream) {
    static int grid_blocks = 0;
    if (grid_blocks == 0) {
        if (n_in != 19 || ws_size < WS_END) { fprintf(stderr, "kernel_launch: expected 19 inputs and >= %zu bytes of workspace; got %d inputs, %zu bytes\n", (size_t)WS_END, n_in, ws_size); grid_blocks = -1; return; }
        int dev = 0, cus = 0, per_cu = 0;
        hipGetDevice(&dev);
        hipDeviceGetAttribute(&cus, hipDeviceAttributeMultiprocessorCount, dev);
        if (hipFuncSetAttribute((const void*)fwd_kernel, hipFuncAttributeMaxDynamicSharedMemorySize, LDS_BYTES) != hipSuccess) fprintf(stderr, "kernel_launch: hipFuncSetAttribute failed\n");
        if (hipOccupancyMaxActiveBlocksPerMultiprocessor(&per_cu, (const void*)fwd_kernel, NWAVES * 64, LDS_BYTES) != hipSuccess || per_cu < 1) { fprintf(stderr, "kernel_launch: occupancy query says %d blocks per CU; using 1\n", per_cu); per_cu = 1; }
        (void)hipGetLastError();
        grid_blocks = cus * per_cu;
    }
    if (grid_blocks < 0) return;
    if (hipMemsetAsync((unsigned char*)d_ws + WS_BAR, 0, XCD_BAR_WORDS * 4, stream) != hipSuccess) fprintf(stderr, "kernel_launch: hipMemsetAsync failed\n");
    Params p{};
    for (int i = 0; i < 19; ++i) p.in[i] = d_in[i];
    p.out = (float*)d_out; p.ws = (unsigned char*)d_ws;
    void* args[] = {&p};
    const hipError_t e = hipLaunchCooperativeKernel((const void*)fwd_kernel, dim3(grid_blocks), dim3(NWAVES * 64), args, LDS_BYTES, stream);
    if (e != hipSuccess) fprintf(stderr, "kernel_launch: cooperative launch failed: %s (grid %d)\n", hipGetErrorString(e), grid_blocks);
}
```
